# Optimizing an MI355X kernel written in HIP

```python
import jax, jax.numpy as jnp
from jax import lax
import numpy as np

D_MODEL = 2048
BATCH = 2
SEQ = 4096
DEPTH = 4

MEM_LEN = 256
HEAD_DIM = 128
GRID_W = 64
NA_HEADS = 6
NA_ROWS = 8
NA_COLS = 16
RET_HEADS = 4
RET_DK = 128
RET_DV = 256
RET_CHUNK = 128
ROPE_BASE = 10000.0
DIL_HEADS = 6
DIL_PAIRS = ((128, 1), (512, 4), (2048, 16))
DIL_BLOCK = 128
T5_BUCKETS = 32
T5_MAX_DIST = 1024
CROSS_HEADS = 4
D_FF = 4 * D_MODEL
EPS = 1e-6
NEG = -1e30

NA_W = NA_HEADS * HEAD_DIM
RET_QK_W = RET_HEADS * RET_DK
RET_V_W = RET_HEADS * RET_DV
DIL_W = DIL_HEADS * HEAD_DIM
CROSS_W = CROSS_HEADS * HEAD_DIM
MIX_W = NA_W + RET_V_W + DIL_W
IN_SPLITS = (NA_W, NA_W, NA_W, RET_QK_W, RET_QK_W, RET_V_W, RET_V_W,
             DIL_W, DIL_W, DIL_W, D_MODEL, D_MODEL, D_MODEL)
IN_W = sum(IN_SPLITS)

kernel_name = "hybrid_natten_retention_dilated_encoder"


def rms_norm(x, g):
    xf = x.astype(jnp.float32)
    y = xf * lax.rsqrt(jnp.mean(jnp.square(xf), axis=-1, keepdims=True) + EPS)
    return (y * g.astype(jnp.float32)).astype(x.dtype)


def split_heads(t, h):
    b, s, w = t.shape
    return t.reshape(b, s, h, w // h).transpose(0, 2, 1, 3)


def merge_heads(t):
    b, h, s, d = t.shape
    return t.transpose(0, 2, 1, 3).reshape(b, s, h * d)


def t5_bucket(rel):
    nb = T5_BUCKETS // 2
    ret = (rel > 0).astype(np.int32) * nb
    n = np.abs(rel)
    max_exact = nb // 2
    large = max_exact + (np.log(np.maximum(n, 1) / max_exact) / np.log(T5_MAX_DIST / max_exact)
                         * (nb - max_exact)).astype(np.int32)
    large = np.minimum(large, nb - 1)
    return (ret + np.where(n < max_exact, n, large)).astype(np.int32)


def neighbourhood_attention(q, k, v, rpb):
    b, h, s, hd = q.shape
    rows = s // GRID_W
    wr = min(NA_ROWS, rows)
    qg = q.reshape(b, h, rows, GRID_W, hd)
    kg = k.reshape(b, h, rows, GRID_W, hd)
    vg = v.reshape(b, h, rows, GRID_W, hd)
    c = np.arange(GRID_W)
    c0 = np.clip(c - NA_COLS // 2, 0, GRID_W - NA_COLS)
    col_idx = c0[:, None] + np.arange(NA_COLS)[None, :]
    col_off = col_idx - c[:, None] + (NA_COLS - 1)
    scale = hd ** -0.5

    def row_block(r):
        r0 = jnp.clip(r - wr // 2, 0, rows - wr)
        q_r = lax.dynamic_index_in_dim(qg, r, axis=2, keepdims=False)
        k_r = lax.dynamic_slice_in_dim(kg, r0, wr, axis=2)[:, :, :, col_idx]
        v_r = lax.dynamic_slice_in_dim(vg, r0, wr, axis=2)[:, :, :, col_idx]
        row_off = r0 + jnp.arange(wr) - r + (NA_ROWS - 1)
        bias = rpb[:, row_off][:, :, col_off].transpose(0, 2, 1, 3)
        logits = (jnp.einsum('bhcd,bhrcjd->bhcrj', q_r, k_r).astype(jnp.float32) * scale
                  + bias[None].astype(jnp.float32))
        p = jax.nn.softmax(logits.reshape(b, h, GRID_W, wr * NA_COLS), axis=-1)
        p = p.reshape(logits.shape).astype(v.dtype)
        return jnp.einsum('bhcrj,bhrcjd->bhcd', p, v_r)

    out = lax.map(row_block, jnp.arange(rows))
    return out.transpose(1, 2, 0, 3, 4).reshape(b, h, s, hd)


def dilated_attention(q, k, v, t5_table):
    b, h, s, hd = q.shape
    scale = hd ** -0.5
    nblk = s // DIL_BLOCK
    groups = []
    for (w, d) in DIL_PAIRS:
        half = w // (2 * d)
        offs = d * np.arange(-half, half + 1)
        bias = t5_table[t5_bucket(offs)].T.astype(jnp.float32)
        groups.append((offs, bias))

    def q_block(i):
        t = i * DIL_BLOCK + jnp.arange(DIL_BLOCK)
        q_b = lax.dynamic_slice_in_dim(q, i * DIL_BLOCK, DIL_BLOCK, axis=2)
        outs, lses = [], []
        for offs, bias in groups:
            idx = t[:, None] + offs[None, :]
            valid = (idx >= 0) & (idx < s)
            idx = jnp.clip(idx, 0, s - 1)
            k_g = jnp.take(k, idx, axis=2)
            v_g = jnp.take(v, idx, axis=2)
            logits = (jnp.einsum('bhqd,bhqkd->bhqk', q_b, k_g).astype(jnp.float32) * scale
                      + bias[None, :, None, :])
            logits = jnp.where(valid[None, None], logits, NEG)
            lse = jax.nn.logsumexp(logits, axis=-1)
            p = jnp.exp(logits - lse[..., None]).astype(v.dtype)
            outs.append(jnp.einsum('bhqk,bhqkd->bhqd', p, v_g))
            lses.append(lse)
        alpha = jax.nn.softmax(jnp.stack(lses, axis=0), axis=0)
        return jnp.einsum('gbhq,gbhqd->bhqd', alpha.astype(v.dtype), jnp.stack(outs, axis=0))

    out = lax.map(q_block, jnp.arange(nblk))
    return out.transpose(1, 2, 0, 3, 4).reshape(b, h, s, hd)


def rotary(x):
    s, d = x.shape[2], x.shape[3]
    inv_freq = jnp.asarray((ROPE_BASE ** (-np.arange(0, d, 2, dtype=np.float32) / d)).astype(np.float32))
    ang = jnp.arange(s, dtype=jnp.float32)[:, None] * inv_freq[None, :]
    cos, sin = jnp.cos(ang), jnp.sin(ang)
    x1, x2 = x[..., : d // 2], x[..., d // 2:]
    return jnp.concatenate([x1 * cos - x2 * sin, x1 * sin + x2 * cos], axis=-1)


def retention_dir(q, k, v, log_g, include_diag):
    b, h, s, dk = q.shape
    dv = v.shape[-1]
    n = s // RET_CHUNK
    j = jnp.arange(RET_CHUNK, dtype=jnp.float32)
    diff = j[:, None] - j[None, :]
    keep = (diff >= 0) if include_diag else (diff > 0)
    dmask = jnp.where(keep, jnp.exp(jnp.where(keep, diff, 0.0) * log_g[:, None, None]), 0.0)
    xi = jnp.exp((j + 1.0) * log_g[:, None])
    zeta = jnp.exp((RET_CHUNK - 1.0 - j) * log_g[:, None])
    g_c = jnp.exp(RET_CHUNK * log_g)

    def chunks(t):
        return t.reshape(b, h, n, RET_CHUNK, t.shape[-1]).transpose(2, 0, 1, 3, 4)

    def step(state, inp):
        qi, ki, vi = inp
        inner = jnp.einsum('bhqd,bhkd->bhqk', qi, ki) * dmask[None]
        o = (jnp.einsum('bhqk,bhkv->bhqv', inner, vi)
             + jnp.einsum('bhqd,bhdv->bhqv', qi, state) * xi[None, :, :, None])
        state = (state * g_c[None, :, None, None]
                 + jnp.einsum('bhkd,bhkv->bhdv', ki, vi * zeta[None, :, :, None]))
        return state, o

    state0 = jnp.zeros((b, h, dk, dv), jnp.float32)
    _, o = lax.scan(step, state0, (chunks(q), chunks(k), chunks(v)))
    return o.transpose(1, 2, 0, 3, 4).reshape(b, h, s, dv)


def retention_mixer(q, k, v, gate, decay_w):
    qh = rotary(split_heads(q, RET_HEADS).astype(jnp.float32))
    kh = rotary(split_heads(k, RET_HEADS).astype(jnp.float32)) * (RET_DK ** -0.5)
    vh = split_heads(v, RET_HEADS).astype(jnp.float32)
    log_g = -jnp.exp(decay_w.astype(jnp.float32))
    fwd = retention_dir(qh, kh, vh, log_g[0], True)
    flip = lambda t: jnp.flip(t, axis=2)
    bwd = flip(retention_dir(flip(qh), flip(kh), flip(vh), log_g[1], False))
    y = fwd + bwd
    mu = jnp.mean(y, axis=-1, keepdims=True)
    var = jnp.mean(jnp.square(y - mu), axis=-1, keepdims=True)
    y = (y - mu) * lax.rsqrt(var + EPS)
    return jax.nn.silu(gate) * merge_heads(y).astype(gate.dtype)


def cross_attention(xn, mn, w_q, w_kv, w_o):
    q = split_heads(xn @ w_q, CROSS_HEADS)
    k, v = jnp.split(mn @ w_kv, 2, axis=-1)
    k, v = split_heads(k, CROSS_HEADS), split_heads(v, CROSS_HEADS)
    logits = jnp.einsum('bhqd,bhkd->bhqk', q, k).astype(jnp.float32) * (HEAD_DIM ** -0.5)
    p = jax.nn.softmax(logits, axis=-1).astype(v.dtype)
    return merge_heads(jnp.einsum('bhqk,bhkd->bhqd', p, v)) @ w_o


def setup_inputs(seed: int = 0) -> dict:
    key = jax.random.key(seed)
    ks = jax.random.split(key, 20)
    f32 = jnp.float32

    def dense(k, shape, fan_in):
        return jax.random.normal(k, shape, f32) * (fan_in ** -0.5)

    def gain(k, shape):
        return 1.0 + 0.02 * jax.random.normal(k, shape, f32)

    hh = np.arange(RET_HEADS, dtype=np.float32)
    w0 = np.log(-np.log(1.0 - 2.0 ** (-5.0 - hh))).astype(np.float32)
    ret_decay = jnp.asarray(w0)[None, None, :] + 0.05 * jax.random.normal(ks[5], (DEPTH, 2, RET_HEADS), f32)
    return {
        "x": jax.random.normal(ks[0], (BATCH, SEQ, D_MODEL), f32),
        "mem": jax.random.normal(ks[1], (BATCH, MEM_LEN, D_MODEL), f32),
        "t5_bias": 0.1 * jax.random.normal(ks[2], (T5_BUCKETS, DIL_HEADS), f32),
        "norm_mix_g": gain(ks[3], (DEPTH, D_MODEL)),
        "w_in": dense(ks[4], (DEPTH, D_MODEL, IN_W), D_MODEL),
        "na_rpb": 0.1 * jax.random.normal(ks[6], (DEPTH, NA_HEADS, 2 * NA_ROWS - 1, 2 * NA_COLS - 1), f32),
        "ret_decay": ret_decay,
        "w_branch": dense(ks[7], (DEPTH, MIX_W, D_MODEL), NA_W),
        "w_out": dense(ks[8], (DEPTH, D_MODEL, D_MODEL), D_MODEL),
        "norm_cross_g": gain(ks[9], (DEPTH, D_MODEL)),
        "norm_mem_g": gain(ks[10], (DEPTH, D_MODEL)),
        "w_cq": dense(ks[11], (DEPTH, D_MODEL, CROSS_W), D_MODEL),
        "w_ckv": dense(ks[12], (DEPTH, D_MODEL, 2 * CROSS_W), D_MODEL),
        "w_co": dense(ks[13], (DEPTH, CROSS_W, D_MODEL), CROSS_W),
        "norm_mlp_g": gain(ks[14], (DEPTH, D_MODEL)),
        "w_mlp1": dense(ks[15], (DEPTH, D_MODEL, D_FF), D_MODEL),
        "w_mlp2": dense(ks[16], (DEPTH, D_FF, D_MODEL), D_FF),
        "final_norm_g": gain(ks[17], (D_MODEL,)),
    }


def reference(x, mem, t5_bias, norm_mix_g, w_in, na_rpb, ret_decay, w_branch, w_out,
              norm_cross_g, norm_mem_g, w_cq, w_ckv, w_co, norm_mlp_g, w_mlp1, w_mlp2,
              final_norm_g):
    split_at = [int(o) for o in np.cumsum(IN_SPLITS)[:-1]]
    for l in range(DEPTH):
        xn = rms_norm(x, norm_mix_g[l])
        u = xn @ w_in[l]
        (qa, ka, va, qb, kb, vb, g_ret, qc, kc, vc,
         s_a, s_b, s_c) = jnp.split(u, split_at, axis=-1)
        o_a = merge_heads(neighbourhood_attention(split_heads(qa, NA_HEADS), split_heads(ka, NA_HEADS),
                                                  split_heads(va, NA_HEADS), na_rpb[l]))
        o_b = retention_mixer(qb, kb, vb, g_ret, ret_decay[l])
        o_c = merge_heads(dilated_attention(split_heads(qc, DIL_HEADS), split_heads(kc, DIL_HEADS),
                                            split_heads(vc, DIL_HEADS), t5_bias))
        wb = w_branch[l]
        merged = (jax.nn.sigmoid(s_a) * (o_a @ wb[:NA_W])
                  + jax.nn.sigmoid(s_b) * (o_b @ wb[NA_W:NA_W + RET_V_W])
                  + jax.nn.sigmoid(s_c) * (o_c @ wb[NA_W + RET_V_W:]))
        x = x + merged @ w_out[l]
        x = x + cross_attention(rms_norm(x, norm_cross_g[l]), rms_norm(mem, norm_mem_g[l]),
                                w_cq[l], w_ckv[l], w_co[l])
        xn = rms_norm(x, norm_mlp_g[l])
        x = x + jnp.square(jax.nn.relu(xn @ w_mlp1[l])) @ w_mlp2[l]
    return rms_norm(x, final_norm_g)
```

```cpp
#include <hip/hip_runtime.h>
#include <cstdio>
#include <cstdint>

#ifndef MK_LAUNCH_PER_PHASE
#define MK_LAUNCH_PER_PHASE 0
#endif

namespace pg8 {
#define PG8_LAS __attribute__((address_space(3)))
typedef unsigned short bf16_t;
typedef short bf16x8 __attribute__((ext_vector_type(8)));
typedef float f32x4 __attribute__((ext_vector_type(4)));
typedef unsigned u32x4 __attribute__((ext_vector_type(4)));
constexpr int BM = 256, BK = 64, HALF = 128, HTB = HALF * BK * 2  , STAGE_BYTES = 8 * HTB, NXCD = 8, WGM = 8;

__host__ __device__ __forceinline__ int lds_byte(int r, int c) { const int st = (r >> 4) * 2 + (c >> 5), rr = r & 15, cc = c & 31, ob = rr * 64 + cc * 2; return st * 1024 + (ob ^ (((ob >> 9) & 1) << 5)); }
__host__ __device__ __forceinline__ void stage_rc(int b, int& R, int& C) { const int st = b / 1024, sb = b % 1024, swz = sb ^ (((sb >> 9) & 1) << 5); R = (st >> 1) * 16 + swz / 64; C = (st & 1) * 32 + (swz % 64) / 2; }
__host__ __device__ __forceinline__ int perm32(int rho) { const int n = rho >> 4, i = rho & 15; return 8 * (i >> 2) + 4 * n + (i & 3); }

struct Unit { int pm, pn, kind; };

__device__ __forceinline__ bool static_tile(int nM, int nN, int G, int c, int i, int& pm, int& pn) {
    const int nwg = nM * nN; const long L = (long)i * G + c; if (L >= nwg) return false;
    int wgid = (int)L; { const int q = nwg / NXCD, r = nwg % NXCD, xcd = wgid % NXCD, off = wgid / NXCD; wgid = (xcd < r ? xcd * (q + 1) : r * (q + 1) + (xcd - r) * q) + off; }
    const int nig = WGM * nN, gid = wgid / nig, fm = gid * WGM, gsz = (nM - fm) < WGM ? (nM - fm) : WGM;
    pm = fm + ((wgid % nig) % gsz); pn = (wgid % nig) / gsz; return true;
}

__device__ __forceinline__ unsigned cvt_pk_bf16(float lo, float hi) { unsigned r; asm volatile("v_cvt_pk_bf16_f32 %0, %1, %2" : "=v"(r) : "v"(lo), "v"(hi)); return r; }

template <class Epi, class Sched, bool ALIGN_EPI = false, bool SP2 = false>
__device__ __forceinline__ void gemm_phase(PG8_LAS unsigned char* lds, const int wave_id, const int ld, const Sched& S, const Epi& E) {
    int lane = (int)__builtin_amdgcn_mbcnt_hi(~0u, __builtin_amdgcn_mbcnt_lo(~0u, 0u)); asm volatile("" : "+v"(lane));
    const int wid = wave_id, tid = wid * 64 + lane, wr = wid >> 2, wc = wid & 3, fr = lane & 15, fq = lane >> 4;
    unsigned voffA[2], voffB[2];
#pragma unroll
    for (int i = 0; i < 2; ++i) { int R, C; stage_rc(tid * 16 + i * 8192, R, C); const int Rb = Epi::PERM ? ((R & ~31) + perm32(R & 31)) : R;
        voffA[i] = (unsigned)(R * ld + C) * 2u; voffB[i] = (unsigned)(Rb * ld + C) * 2u; }
    const size_t kstep = (size_t)(BK * 2);
    const size_t hstep = (size_t)HALF * ld * 2;
    const unsigned ldsw = (unsigned)wid * 1024u;
    const int aoff = lds_byte(wr * 64 + fr, fq * 8), boff = lds_byte(wc * 32 + fr, fq * 8);
#define PG8_SA(b, h) (((b) * 2 + (h)) * HTB)
#define PG8_SB(b, h) ((4 + (b) * 2 + (h)) * HTB)
#define PG8_STAGE(bufoff, gbase, voff) do { _Pragma("unroll") for (int _i = 0; _i < 2; ++_i) \
        __builtin_amdgcn_global_load_lds((const unsigned*)((const char*)(gbase) + (voff)[_i]), (PG8_LAS unsigned*)(lds + (bufoff) + ldsw + _i * 8192), 16, 0, 0); } while (0)
#define PG8_LDA(dst, b, h) do { _Pragma("unroll") for (int m = 0; m < 4; ++m) _Pragma("unroll") for (int k = 0; k < 2; ++k) dst[m][k] = *(const PG8_LAS bf16x8*)(lds + PG8_SA(b, h) + aoff + m * 2048 + k * 1024); } while (0)
#define PG8_LDB(dst, b, h) do { _Pragma("unroll") for (int n = 0; n < 2; ++n) _Pragma("unroll") for (int k = 0; k < 2; ++k) dst[n][k] = *(const PG8_LAS bf16x8*)(lds + PG8_SB(b, h) + boff + n * 2048 + k * 1024); } while (0)
#define PG8_MMA(ai, bj, At, Bt) do { __builtin_amdgcn_s_setprio(1); _Pragma("unroll") for (int m = 0; m < 4; ++m) _Pragma("unroll") for (int n = 0; n < 2; ++n) _Pragma("unroll") for (int k = 0; k < 2; ++k) \
        acc[ai][bj][m][n] = __builtin_amdgcn_mfma_f32_16x16x32_bf16(Bt[n][k], At[m][k], acc[ai][bj][m][n], 0, 0, 0); __builtin_amdgcn_s_setprio(0); } while (0)
#define PG8_WAIT_V(n) asm volatile("s_waitcnt vmcnt(" #n ")" ::: "memory")
#define PG8_WAIT_L(n) asm volatile("s_waitcnt lgkmcnt(" #n ")" ::: "memory")
#define PG8_BAR __builtin_amdgcn_s_barrier()
#define PG8_SCHED __builtin_amdgcn_sched_barrier(0)
    Unit cur, nxt; int ui = 0;
    if (!S.next(0, cur)) return;
    f32x4 acc[2][2][4][2];
#pragma unroll
    for (int a = 0; a < 2; ++a)
#pragma unroll
        for (int b = 0; b < 2; ++b)
#pragma unroll
            for (int m = 0; m < 4; ++m)
#pragma unroll
                for (int n = 0; n < 2; ++n) acc[a][b][m][n] = (f32x4){0.f, 0.f, 0.f, 0.f};
    bf16x8 At[4][2], B0[2][2], B1[2][2];
    const char* cA; const char* cB; int nt;
    S.ptrs(cur, cA, cB, nt);
    if constexpr (SP2) {
        PG8_STAGE(PG8_SB(0, 0), cB, voffB); PG8_STAGE(PG8_SB(0, 1), cB + hstep, voffB); PG8_STAGE(PG8_SA(0, 0), cA, voffA); PG8_STAGE(PG8_SA(0, 1), cA + hstep, voffA);
        if (wr == 1) PG8_BAR;
        PG8_WAIT_V(2); PG8_BAR;
        PG8_STAGE(PG8_SB(1, 0), cB + kstep, voffB); PG8_STAGE(PG8_SA(1, 0), cA + kstep, voffA); PG8_STAGE(PG8_SB(1, 1), cB + hstep + kstep, voffB);
        PG8_WAIT_V(6); PG8_BAR;
    } else {
        PG8_STAGE(PG8_SB(0, 0), cB, voffB); PG8_STAGE(PG8_SA(0, 0), cA, voffA); PG8_STAGE(PG8_SB(0, 1), cB + hstep, voffB); PG8_STAGE(PG8_SA(0, 1), cA + hstep, voffA);
        if (wr == 1) PG8_BAR;
        PG8_WAIT_V(4); PG8_BAR;
        PG8_STAGE(PG8_SB(1, 0), cB + kstep, voffB); PG8_STAGE(PG8_SA(1, 0), cA + kstep, voffA); PG8_STAGE(PG8_SB(1, 1), cB + hstep + kstep, voffB);
        PG8_WAIT_V(6); PG8_BAR;
    }
    for (;;) {
        const bool has_next = S.next(ui + 1, nxt);
        const char* nA = cA; const char* nB = cB; int nnt = nt;
        if (has_next) S.ptrs(nxt, nA, nB, nnt);
        for (int t = 0; t < nt; t += 2) {
            const bool last = (t == nt - 2);
            const char* a1 = cA + (size_t)(t + 1) * kstep;
            const char* a2 = last ? nA : cA + (size_t)(t + 2) * kstep; const char* b2 = last ? nB : cB + (size_t)(t + 2) * kstep;
            const char* a3 = a2 + kstep; const char* b3 = b2 + kstep;
            if constexpr (SP2) {
            PG8_LDB(B0, 0, 0); PG8_LDB(B1, 0, 1); PG8_SCHED; PG8_LDA(At, 0, 0); PG8_STAGE(PG8_SA(1, 1), a1 + hstep, voffA);
            PG8_WAIT_V(8); PG8_WAIT_L(0); PG8_BAR; PG8_MMA(0, 0, At, B0); PG8_MMA(0, 1, At, B1); PG8_BAR; PG8_SCHED;
            PG8_LDA(At, 0, 1); PG8_STAGE(PG8_SB(0, 0), b2, voffB); PG8_STAGE(PG8_SB(0, 1), b2 + hstep, voffB); PG8_STAGE(PG8_SA(0, 0), a2, voffA);
            PG8_WAIT_V(8); PG8_WAIT_L(0); PG8_BAR; PG8_MMA(1, 0, At, B0); PG8_MMA(1, 1, At, B1); PG8_BAR; PG8_SCHED;
            PG8_LDB(B0, 1, 0); PG8_LDB(B1, 1, 1); PG8_SCHED; PG8_LDA(At, 1, 0); PG8_STAGE(PG8_SA(0, 1), a2 + hstep, voffA);
            PG8_WAIT_V(8); PG8_WAIT_L(0); PG8_BAR; PG8_MMA(0, 0, At, B0); PG8_MMA(0, 1, At, B1); PG8_BAR; PG8_SCHED;
            PG8_LDA(At, 1, 1); PG8_STAGE(PG8_SB(1, 0), b3, voffB); PG8_STAGE(PG8_SB(1, 1), b3 + hstep, voffB); PG8_STAGE(PG8_SA(1, 0), a3, voffA);
            PG8_WAIT_V(8); PG8_WAIT_L(0); PG8_BAR; PG8_MMA(1, 0, At, B0); PG8_MMA(1, 1, At, B1); PG8_BAR; PG8_SCHED;
            } else {
            PG8_LDB(B0, 0, 0); PG8_SCHED; PG8_LDA(At, 0, 0); PG8_STAGE(PG8_SA(1, 1), a1 + hstep, voffA);
            PG8_WAIT_L(8); PG8_BAR; PG8_WAIT_L(0); PG8_MMA(0, 0, At, B0); PG8_BAR; PG8_SCHED;
            PG8_LDB(B1, 0, 1); PG8_STAGE(PG8_SB(0, 0), b2, voffB);
            PG8_BAR; PG8_WAIT_L(0); PG8_MMA(0, 1, At, B1); PG8_BAR;
            PG8_LDA(At, 0, 1); PG8_STAGE(PG8_SA(0, 0), a2, voffA);
            PG8_BAR; PG8_WAIT_L(0); PG8_MMA(1, 0, At, B0); PG8_BAR; PG8_SCHED;
            PG8_STAGE(PG8_SB(0, 1), b2 + hstep, voffB);
            PG8_WAIT_V(6); PG8_BAR; PG8_MMA(1, 1, At, B1); PG8_BAR;
            PG8_LDB(B0, 1, 0); PG8_SCHED; PG8_LDA(At, 1, 0); PG8_STAGE(PG8_SA(0, 1), a2 + hstep, voffA);
            PG8_WAIT_L(8); PG8_BAR; PG8_WAIT_L(0); PG8_MMA(0, 0, At, B0); PG8_BAR; PG8_SCHED;
            PG8_LDB(B1, 1, 1); PG8_STAGE(PG8_SB(1, 0), b3, voffB);
            PG8_BAR; PG8_WAIT_L(0); PG8_MMA(0, 1, At, B1); PG8_BAR;
            PG8_LDA(At, 1, 1); PG8_STAGE(PG8_SA(1, 0), a3, voffA);
            PG8_BAR; PG8_WAIT_L(0); PG8_MMA(1, 0, At, B0); PG8_BAR; PG8_SCHED;
            PG8_STAGE(PG8_SB(1, 1), b3 + hstep, voffB);
            PG8_WAIT_V(6); PG8_BAR; PG8_MMA(1, 1, At, B1); PG8_BAR;
            }
        }
        if constexpr (ALIGN_EPI) { if (wr == 0) PG8_BAR; }
        E(acc, cur, wr, wc, fr, fq);
        if (!has_next) break;
#pragma unroll
        for (int a = 0; a < 2; ++a)
#pragma unroll
            for (int b = 0; b < 2; ++b)
#pragma unroll
                for (int m = 0; m < 4; ++m)
#pragma unroll
                    for (int n = 0; n < 2; ++n) acc[a][b][m][n] = (f32x4){0.f, 0.f, 0.f, 0.f};
        cur = nxt; cA = nA; cB = nB; nt = nnt; ++ui;
        if constexpr (ALIGN_EPI) { if (wr == 1) PG8_BAR; }
    }
    PG8_WAIT_V(0);
    if constexpr (!ALIGN_EPI) { if (wr == 0) PG8_BAR; }
    PG8_BAR;
#undef PG8_SA
#undef PG8_SB
#undef PG8_STAGE
#undef PG8_LDA
#undef PG8_LDB
#undef PG8_MMA
#undef PG8_WAIT_V
#undef PG8_WAIT_L
#undef PG8_BAR
#undef PG8_SCHED
}
}

#ifndef PG8_SP2
#define PG8_SP2 true
#endif
#ifndef PG8_ALIGN
#define PG8_ALIGN true
#endif

constexpr int NWAVES = 8;
constexpr int DM = 2048, NB = 2, SEQ = 4096, MT = NB * SEQ, DEPTH = 4, MEML = 256, MEMT = NB * MEML;
constexpr int INW = 13824, MIXW = 2560, FF = 8192, CRW = 512;
constexpr int U_QA = 0, U_KA = 768, U_VA = 1536, U_QB = 2304, U_KB = 2816, U_VB = 3328, U_GR = 4352, U_QC = 5376, U_KC = 6144, U_VC = 6912, U_SA = 7680;
constexpr float EPSF = 1e-6f, LOG2E = 1.4426950408889634f;
constexpr float QSCALE = 0.08838834764831845f;

constexpr size_t MiB = 1u << 20;
constexpr size_t WS_CTL = 0, CTL_ZERO_BYTES = 1 * MiB;
constexpr size_t WS_ROPE = 2 * MiB;
constexpr size_t WS_WIN = 8 * MiB;
constexpr size_t SZ_WIN = (size_t)DEPTH * INW * DM * 2;
constexpr size_t WS_WBR = WS_WIN + SZ_WIN;
constexpr size_t SZ_WBR = (size_t)DEPTH * DM * MIXW * 2;
constexpr size_t WS_WOUT = WS_WBR + SZ_WBR;
constexpr size_t SZ_WOUT = (size_t)DEPTH * DM * DM * 2;
constexpr size_t WS_WCQ = WS_WOUT + SZ_WOUT;
constexpr size_t SZ_WCQ = (size_t)DEPTH * CRW * DM * 2;
constexpr size_t WS_WCKV = WS_WCQ + SZ_WCQ;
constexpr size_t SZ_WCKV = (size_t)DEPTH * 2 * CRW * DM * 2;
constexpr size_t WS_WCO = WS_WCKV + SZ_WCKV;
constexpr size_t SZ_WCO = (size_t)DEPTH * DM * CRW * 2;
constexpr size_t WS_W1 = WS_WCO + SZ_WCO;
constexpr size_t SZ_W1 = (size_t)DEPTH * FF * DM * 2;
constexpr size_t WS_W2 = WS_W1 + SZ_W1;
constexpr size_t SZ_W2 = (size_t)DEPTH * DM * FF * 2;
constexpr size_t WS_MN = WS_W2 + SZ_W2;
constexpr size_t SZ_MN = (size_t)DEPTH * MEMT * DM * 2;
constexpr size_t WS_X = WS_MN + SZ_MN;
constexpr size_t SZ_X = (size_t)MT * DM * 4;
constexpr size_t WS_XN = WS_X + SZ_X;
constexpr size_t SZ_XN = (size_t)MT * DM * 2;
constexpr size_t WS_U = WS_XN + SZ_XN;
constexpr size_t SZ_U = (size_t)MT * INW * 2;
constexpr size_t WS_H = WS_U;
constexpr size_t WS_VBT = WS_U + SZ_U;
constexpr size_t SZ_VBT = (size_t)1024 * MT * 2;
constexpr size_t WS_KBT = WS_VBT + SZ_VBT;
constexpr size_t SZ_KBT = (size_t)512 * MT * 2;
constexpr size_t WS_ST = WS_KBT + SZ_KBT;
constexpr size_t SZ_ST = (size_t)2 * 2 * 4 * 32 * 256 * 128 * 2;
constexpr size_t WS_OMIX = WS_ST + SZ_ST;
constexpr size_t SZ_OMIX = (size_t)MT * MIXW * 2;
constexpr size_t WS_PO = WS_OMIX + SZ_OMIX;
constexpr size_t SZ_PO = (size_t)2 * MT * 768 * 4;
constexpr size_t WS_PL = WS_PO + SZ_PO;
constexpr size_t SZ_PL = (size_t)2 * MT * 8 * 4;
constexpr size_t WS_MPART = WS_PL + SZ_PL;
constexpr size_t SZ_MPART = (size_t)MT * DM * 4;
constexpr size_t WS_MERGED = WS_MPART + SZ_MPART;
constexpr size_t SZ_MERGED = (size_t)MT * DM * 2;
constexpr size_t WS_QX = WS_MERGED + SZ_MERGED;
constexpr size_t SZ_QX = (size_t)MT * CRW * 2;
constexpr size_t WS_KX = WS_QX + SZ_QX;
constexpr size_t SZ_KX = (size_t)MEMT * CRW * 2;
constexpr size_t WS_VXT = WS_KX + SZ_KX;
constexpr size_t SZ_VXT = (size_t)CRW * MEMT * 2;
constexpr size_t WS_AX = WS_VXT + SZ_VXT;
constexpr size_t SZ_AX = (size_t)MT * CRW * 2;
constexpr size_t WS_END = WS_AX + SZ_AX;
static_assert((size_t)MT * FF * 2 <= SZ_U, "h overlays u");

constexpr int CW_TMO = 0, CW_CODE = 1;
constexpr int CW_BAR = 4096;

constexpr int RING_OFF = 0, RING_BYTES = 131072;
constexpr int LDSCTL_OFF = RING_BYTES, MISC_OFF = LDSCTL_OFF + 320;
constexpr int LDS_BYTES = 147456;
constexpr int LDS_RPB = 65536, LDS_T5 = 65536 + 12288;
static_assert(MISC_OFF + 128 <= LDS_BYTES, "LDS map");

#define GAS __attribute__((address_space(1)))
#define LAS __attribute__((address_space(3)))
typedef unsigned short bf16;
typedef unsigned v4u __attribute__((ext_vector_type(4)));
typedef unsigned v2u __attribute__((ext_vector_type(2)));
typedef float f32x4 __attribute__((ext_vector_type(4)));
typedef float f32x2 __attribute__((ext_vector_type(2)));
typedef short bf16x8 __attribute__((ext_vector_type(8)));
typedef short s16x4 __attribute__((ext_vector_type(4)));
typedef GAS unsigned gu32;
#define RLX_AGENT __ATOMIC_RELAXED, __HIP_MEMORY_SCOPE_AGENT
#define LDS_WAIT() asm volatile("s_waitcnt lgkmcnt(0)" ::: "memory")
#define VM_WAIT() asm volatile("s_waitcnt vmcnt(0)" ::: "memory")
__device__ __forceinline__ unsigned f2bf(float f) { unsigned u = __builtin_bit_cast(unsigned, f); return (u + 0x7fffu + ((u >> 16) & 1u)) >> 16; }
__device__ __forceinline__ unsigned pk2(float lo, float hi) { return f2bf(lo) | (f2bf(hi) << 16); }
__device__ __forceinline__ float bf2f(unsigned short b) { return __builtin_bit_cast(float, (unsigned)b << 16); }
__device__ __forceinline__ float bflo(unsigned w) { return __builtin_bit_cast(float, w << 16); }
__device__ __forceinline__ float bfhi(unsigned w) { return __builtin_bit_cast(float, w & 0xffff0000u); }
#define MFMA16(a, b, c) __builtin_amdgcn_mfma_f32_16x16x32_bf16((a), (b), (c), 0, 0, 0)
__device__ __forceinline__ bf16x8 ldg8(const bf16* p) { return *(const bf16x8*)p; }
__device__ __forceinline__ bf16x8 pack8(const float* v) { v4u w; w.x = pk2(v[0], v[1]); w.y = pk2(v[2], v[3]); w.z = pk2(v[4], v[5]); w.w = pk2(v[6], v[7]); return __builtin_bit_cast(bf16x8, w); }

#define XB_TMO      128
#define XB_XCNT(j)  (256  + 64 * (j))
#define XB_XSUB(j)  (1280 + 64 * (j))
#define XB_XGEN(j)  (2304 + 64 * (j))
#define XB_TOP      3328
#define XB_TOPGEN   3392
#define XCD_BAR_WORDS 3456
#define XB_SPIN_CAP (1u << 18)

__device__ __forceinline__ unsigned xb_ld(unsigned* p)              { return __hip_atomic_load(p, __ATOMIC_RELAXED, __HIP_MEMORY_SCOPE_AGENT); }
__device__ __forceinline__ unsigned xb_add(unsigned* p, unsigned v) { return __hip_atomic_fetch_add(p, v, __ATOMIC_RELAXED, __HIP_MEMORY_SCOPE_AGENT); }
__device__ __forceinline__ unsigned xb_xcc_id() { return (unsigned)__builtin_amdgcn_s_getreg((3 << 11) | 20) & 0xFu; }
#define XB_SPIN(cond, bar) do { unsigned _sp = 0; while (cond) { __builtin_amdgcn_s_sleep(1); \
    if ((++_sp & 255u) == 0u) { if (xb_ld(&(bar)[XB_TMO])) break; if (_sp > XB_SPIN_CAP) { atomicAdd(&(bar)[XB_TMO], 1u); break; } } } } while (0)

struct XcdBarrier {
    unsigned* bar; unsigned x;
    volatile LAS unsigned* st;
};
__device__ __forceinline__ XcdBarrier xcd_barrier_post(unsigned* bar, volatile LAS unsigned* st, const bool t0) {
    XcdBarrier b; b.bar = bar; b.x = xb_xcc_id(); b.st = st;
    if (t0) (void)xb_add(&bar[XB_XCNT(b.x)], 1u);
    return b;
}
__device__ __forceinline__ void xcd_barrier_complete(unsigned* bar, unsigned x, unsigned& nloc, unsigned& nx) {
    const unsigned G = gridDim.x * gridDim.y * gridDim.z;
    unsigned sum, cnt, mine, sp = 0u;
    for (;;) {
        sum = 0u; cnt = 0u; mine = 0u;
#pragma unroll
        for (unsigned j = 0; j < 16; ++j) { const unsigned c = xb_ld(&bar[XB_XCNT(j)]); sum += c; cnt += (c > 0u) ? 1u : 0u; mine = (j == x) ? c : mine; }
        if (sum == G) break;
        __builtin_amdgcn_s_sleep(1);
        if ((++sp & 255u) == 0u) { if (xb_ld(&bar[XB_TMO])) break; if (sp > XB_SPIN_CAP) { atomicAdd(&bar[XB_TMO], 1u); break; } }
    }
    nloc = mine > 0u ? mine : 1u; nx = cnt > 0u ? cnt : 1u;
}
__device__ __forceinline__ void xcd_barrier(const XcdBarrier& b, const bool t0) {
    asm volatile("s_waitcnt vmcnt(0)" ::: "memory");
    __syncthreads();
    if (t0) {
        unsigned* bar = b.bar;
        __builtin_amdgcn_s_waitcnt(0);
        unsigned nloc = b.st[0], nx = b.st[1];
        if (nloc == 0u) { xcd_barrier_complete(bar, b.x, nloc, nx); b.st[0] = nloc; b.st[1] = nx; }
        const unsigned old = xb_add(&bar[XB_XSUB(b.x)], 1u);
        const unsigned gen = old / nloc;
        if (old + 1u == (gen + 1u) * nloc) {
            __builtin_amdgcn_fence(__ATOMIC_RELEASE, "agent");
            asm volatile("s_waitcnt vmcnt(0)" ::: "memory");
            const unsigned og = xb_add(&bar[XB_TOP], 1u);
            const unsigned tg = og / nx;
            if (og + 1u == (tg + 1u) * nx) xb_add(&bar[XB_TOPGEN], 1u);
            else XB_SPIN(xb_ld(&bar[XB_TOPGEN]) == tg, bar);
            __builtin_amdgcn_fence(__ATOMIC_ACQUIRE, "agent");
            xb_add(&bar[XB_XGEN(b.x)], 1u);
            asm volatile("s_waitcnt vmcnt(0)" ::: "memory");
        } else {
            XB_SPIN(xb_ld(&bar[XB_XGEN(b.x)]) == gen, bar);
            __builtin_amdgcn_fence(__ATOMIC_ACQUIRE, "agent");
            asm volatile("s_waitcnt vmcnt(0)" ::: "memory");
        }
    }
    __syncthreads();
}

struct Frame {
    LAS unsigned char* lds;
    int wave;
    int vcu, G;
    int gw, ngw;
};

__device__ __forceinline__ int lane_id() { int l = (int)__builtin_amdgcn_mbcnt_hi(~0u, __builtin_amdgcn_mbcnt_lo(~0u, 0u)); asm volatile("" : "+v"(l)); return l; }
__device__ __forceinline__ float wave_sum(float v) {
#pragma unroll
    for (int o = 1; o < 64; o <<= 1) v += __shfl_xor(v, o);
    return v;
}

__device__ __forceinline__ float rope_inv_freq(int i) {
    constexpr float t[64] = {0x1.000000p+0f, 0x1.bb5faep-1f, 0x1.7ff224p-1f, 0x1.4c7bc0p-1f, 0x1.1feb34p-1f, 0x1.f2a79ep-2f, 0x1.afd136p-2f, 0x1.75f034p-2f, 0x1.43d136p-2f, 0x1.186a08p-2f, 0x1.e5a848p-3f, 0x1.a48fdap-3f, 0x1.6c310ep-3f, 0x1.3b6080p-3f, 0x1.111aecp-3f, 0x1.d8ffacp-4f,
        0x1.99999ap-4f, 0x1.62b2f0p-4f, 0x1.33281ap-4f, 0x1.09fc9ap-4f, 0x1.ccab86p-5f, 0x1.8eec7ep-5f, 0x1.59742cp-5f, 0x1.2b2690p-5f, 0x1.030dc4p-5f, 0x1.c0a9a6p-6f, 0x1.8486a0p-6f, 0x1.507316p-6f, 0x1.235a72p-6f, 0x1.f89a66p-7f, 0x1.b4f7e4p-7f, 0x1.7a6624p-7f,
        0x1.47ae14p-7f, 0x1.1bc25ap-7f, 0x1.eb735ep-8f, 0x1.a99428p-8f, 0x1.708938p-8f, 0x1.3f2398p-8f, 0x1.145ceep-8f, 0x1.dea41ap-9f, 0x1.9e7c6ep-9f, 0x1.66ee1ep-9f, 0x1.36d218p-9f, 0x1.0d28dcp-9f, 0x1.d22a50p-10f, 0x1.93aeb8p-10f, 0x1.5d931cp-10f, 0x1.2eb81ap-10f,
        0x1.0624dep-10f, 0x1.c603c4p-11f, 0x1.89291ap-11f, 0x1.547688p-11f, 0x1.26d42cp-11f, 0x1.fe9f5ap-12f, 0x1.ba2e4cp-12f, 0x1.7ee9b0p-12f, 0x1.4b96bep-12f, 0x1.1f24e4p-12f, 0x1.f15028p-13f, 0x1.aea7cap-13f, 0x1.74eea6p-13f, 0x1.42f22cp-13f, 0x1.17a8e4p-13f, 0x1.e459c6p-14f};
    float r = 0.f;
#pragma unroll
    for (int k = 0; k < 64; ++k) r = (i == k) ? t[k] : r;
    return r;
}
__device__ __forceinline__ void sincos_f32(float angf, float& s, float& c) {
    const double x = (double)angf;
    const double k = __builtin_rint(x * 0.63661977236758134308);
    const double y = (x - k * 1.5707963267948966192) - k * 6.123233995736766e-17;
    const double y2 = y * y;
    double sp = 1.0 / 1307674368000.0;
    sp = -sp * y2 + 1.0 / 6227020800.0; sp = -sp * y2 + 1.0 / 39916800.0; sp = -sp * y2 + 1.0 / 362880.0; sp = -sp * y2 + 1.0 / 5040.0; sp = -sp * y2 + 1.0 / 120.0; sp = -sp * y2 + 1.0 / 6.0; sp = -sp * y2 + 1.0;
    const double sy = sp * y;
    double cp = 1.0 / 87178291200.0;
    cp = -cp * y2 + 1.0 / 479001600.0; cp = -cp * y2 + 1.0 / 3628800.0; cp = -cp * y2 + 1.0 / 40320.0; cp = -cp * y2 + 1.0 / 720.0; cp = -cp * y2 + 1.0 / 24.0; cp = -cp * y2 + 0.5; cp = -cp * y2 + 1.0;
    const int q = ((int)k) & 3;
    const double ss = (q == 0) ? sy : (q == 1) ? cp : (q == 2) ? -sy : -cp;
    const double cc = (q == 0) ? cp : (q == 1) ? -sy : (q == 2) ? -cp : sy;
    s = (float)ss; c = (float)cc;
}

template <int MAP>
__device__ __forceinline__ void p0_transpose_item(const float* W, int K, int N, bf16* WT, LAS float* scr, int item, int lane) {
    const int nblk = N / 32, kb = item / nblk, nb = item % nblk, k0 = 64 * kb, n0 = 32 * nb;
    int src = n0 + (lane & 31); float sc = 1.f;
    if (MAP == 1) {
        const int n = n0 + (lane & 31);
        if (n >= U_QB && n < U_VB) { const int hbase = n & ~127, p = n & 127; src = hbase + (p >> 1) + 64 * (p & 1); if (n >= U_KB) sc = QSCALE; }
        else if (n < U_KA || (n >= U_QC && n < U_KC)) sc = QSCALE * LOG2E;
    }
    if (MAP == 2) sc = QSCALE * LOG2E;
#pragma unroll 8
    for (int i = 0; i < 32; ++i) { const int kk = 2 * i + (lane >> 5); scr[kk * 33 + (lane & 31)] = W[(size_t)(k0 + kk) * N + src] * sc; }
    LDS_WAIT(); asm volatile("" ::: "memory");
    const int c = lane & 7;
#pragma unroll
    for (int j = 0; j < 4; ++j) { const int n = (lane >> 3) + 8 * j; const LAS float* s = scr + (8 * c) * 33 + n;
        v4u o; o.x = pk2(s[0 * 33], s[1 * 33]); o.y = pk2(s[2 * 33], s[3 * 33]); o.z = pk2(s[4 * 33], s[5 * 33]); o.w = pk2(s[6 * 33], s[7 * 33]);
        *(GAS v4u*)(WT + (size_t)(n0 + n) * K + k0 + 8 * c) = o; }
    LDS_WAIT(); asm volatile("" ::: "memory");
}

__device__ __forceinline__ void rms_row_to_bf16(const float* xrow, const float* g, bf16* orow, int lane) {
    const GAS f32x4* xr = (const GAS f32x4*)xrow + lane; const GAS f32x4* gr = (const GAS f32x4*)g + lane;
    f32x4 v[8]; float s = 0.f;
#pragma unroll
    for (int j = 0; j < 8; ++j) { v[j] = xr[64 * j]; s += (v[j].x * v[j].x + v[j].y * v[j].y) + (v[j].z * v[j].z + v[j].w * v[j].w); }
    const float rs = 1.0f / sqrtf(wave_sum(s) * (1.f / DM) + EPSF);
    GAS v2u* o8 = (GAS v2u*)orow + lane;
#pragma unroll
    for (int j = 0; j < 8; ++j) { const f32x4 gg = gr[64 * j]; v2u w; w.x = pk2(v[j].x * rs * gg.x, v[j].y * rs * gg.y); w.y = pk2(v[j].z * rs * gg.z, v[j].w * rs * gg.w); o8[64 * j] = w; }
}
__device__ __forceinline__ void rms_row_to_f32(const float* xrow, const float* g, float* orow, int lane) {
    const GAS f32x4* xr = (const GAS f32x4*)xrow + lane; const GAS f32x4* gr = (const GAS f32x4*)g + lane;
    f32x4 v[8]; float s = 0.f;
#pragma unroll
    for (int j = 0; j < 8; ++j) { v[j] = xr[64 * j]; s += (v[j].x * v[j].x + v[j].y * v[j].y) + (v[j].z * v[j].z + v[j].w * v[j].w); }
    const float rs = 1.0f / sqrtf(wave_sum(s) * (1.f / DM) + EPSF);
    GAS f32x4* o = (GAS f32x4*)orow + lane;
#pragma unroll
    for (int j = 0; j < 8; ++j) { const f32x4 gg = gr[64 * j]; o[64 * j] = v[j] * rs * gg; }
}

using pg8::Unit;
constexpr size_t TSTEP_DM = (size_t)256 * DM * 2;

struct SchedIn {
    const char* xn; const char* wt; int G, c;
    __device__ __forceinline__ bool next(int i, Unit& u) const {
        int pm, vn; if (!pg8::static_tile(32, 56, G, c, i, pm, vn)) return false;
        u.pm = pm; u.pn = vn; u.kind = (vn >= 54) ? 3 : (vn >= 13 && vn < 17) ? 2 : (vn >= 9 && vn < 13) ? 1 : 0; return true;
    }
    __device__ __forceinline__ void ptrs(const Unit& u, const char*& a, const char*& b, int& nt) const {
        nt = DM / 64;
        if (u.kind >= 2) { const int f = (u.kind == 3) ? 11 + (u.pn - 54) : u.pn; a = wt + (size_t)f * TSTEP_DM; b = xn + (size_t)u.pm * TSTEP_DM; }
        else { a = xn + (size_t)u.pm * TSTEP_DM; b = wt + (size_t)u.pn * TSTEP_DM; }
    }
};
struct EpiIn {
    static constexpr bool PERM = true;
    bf16* u; bf16* vbT; bf16* kbT; const float* rope;
    __device__ __forceinline__ void operator()(const f32x4 (&acc)[2][2][4][2], const Unit& un, int wr, int wc, int fr, int fq) const {
        asm volatile("" : "+v"(fr), "+v"(fq));
        const int r0 = wr * 64 + fr, c0 = wc * 32 + 8 * fq;
        if (un.kind == 0) {
#pragma unroll
            for (int ai = 0; ai < 2; ++ai)
#pragma unroll
                for (int m = 0; m < 4; ++m) { bf16* rowp = u + (size_t)(un.pm * 256 + r0 + ai * 128 + m * 16) * INW + un.pn * 256 + c0;
#pragma unroll
                    for (int bj = 0; bj < 2; ++bj) { const f32x4 v0 = acc[ai][bj][m][0], v1 = acc[ai][bj][m][1];
                        v4u w; w.x = pg8::cvt_pk_bf16(v0[0], v0[1]); w.y = pg8::cvt_pk_bf16(v0[2], v0[3]); w.z = pg8::cvt_pk_bf16(v1[0], v1[1]); w.w = pg8::cvt_pk_bf16(v1[2], v1[3]);
                        *(v4u*)(rowp + bj * 128) = w; } }
        } else if (un.kind == 1) {
            const int i0 = 16 * wc + 4 * fq;
#pragma unroll
            for (int ai = 0; ai < 2; ++ai)
#pragma unroll
                for (int m = 0; m < 4; ++m) { const int row = un.pm * 256 + r0 + ai * 128 + m * 16, t = row & (SEQ - 1);
                    const f32x4 cs = *(const f32x4*)(rope + (size_t)t * 64 + i0), sn = *(const f32x4*)(rope + (size_t)SEQ * 64 + (size_t)t * 64 + i0);
                    bf16* rowp = u + (size_t)row * INW + un.pn * 256 + c0;
#pragma unroll
                    for (int bj = 0; bj < 2; ++bj) { const f32x4 v0 = acc[ai][bj][m][0], v1 = acc[ai][bj][m][1];
                        v4u w; w.x = pg8::cvt_pk_bf16(v0[0] * cs[0] - v0[1] * sn[0], v0[0] * sn[0] + v0[1] * cs[0]);
                        w.y = pg8::cvt_pk_bf16(v0[2] * cs[1] - v0[3] * sn[1], v0[2] * sn[1] + v0[3] * cs[1]);
                        w.z = pg8::cvt_pk_bf16(v1[0] * cs[2] - v1[1] * sn[2], v1[0] * sn[2] + v1[1] * cs[2]);
                        w.w = pg8::cvt_pk_bf16(v1[2] * cs[3] - v1[3] * sn[3], v1[2] * sn[3] + v1[3] * cs[3]);
                        *(v4u*)(rowp + bj * 128) = w; } }
        } else if (un.kind == 2) {
#pragma unroll
            for (int ai = 0; ai < 2; ++ai)
#pragma unroll
                for (int m = 0; m < 4; ++m) { bf16* rowp = vbT + (size_t)((un.pn - 13) * 256 + r0 + ai * 128 + m * 16) * MT + un.pm * 256 + c0;
#pragma unroll
                    for (int bj = 0; bj < 2; ++bj) { const f32x4 v0 = acc[ai][bj][m][0], v1 = acc[ai][bj][m][1];
                        v4u w; w.x = pg8::cvt_pk_bf16(v0[0], v0[1]); w.y = pg8::cvt_pk_bf16(v0[2], v0[3]); w.z = pg8::cvt_pk_bf16(v1[0], v1[1]); w.w = pg8::cvt_pk_bf16(v1[2], v1[3]);
                        *(v4u*)(rowp + bj * 128) = w; } }
        } else {
            const bool odd = fr & 1;
            const float* cosT = rope + (size_t)2 * SEQ * 64; const float* sinT = rope + (size_t)3 * SEQ * 64;
#pragma unroll
            for (int ai = 0; ai < 2; ++ai)
#pragma unroll
                for (int m = 0; m < 4; ++m) { const int rr = r0 + ai * 128 + m * 16, fi = (rr & 127) >> 1;
                    bf16* rowp = kbT + (size_t)((un.pn - 54) * 256 + rr) * MT + un.pm * 256 + c0;
#pragma unroll
                    for (int bj = 0; bj < 2; ++bj) { const int t = (un.pm * 256 + c0 + bj * 128) & (SEQ - 1);
                        const f32x4 cA = *(const f32x4*)(cosT + (size_t)fi * SEQ + t), cB = *(const f32x4*)(cosT + (size_t)fi * SEQ + t + 4);
                        const f32x4 sA = *(const f32x4*)(sinT + (size_t)fi * SEQ + t), sB = *(const f32x4*)(sinT + (size_t)fi * SEQ + t + 4);
                        const f32x4 v0 = acc[ai][bj][m][0], v1 = acc[ai][bj][m][1];
                        float o[8];
#pragma unroll
                        for (int e = 0; e < 4; ++e) { const float p0 = __shfl_xor(v0[e], 1), p1 = __shfl_xor(v1[e], 1);
                            o[e]     = odd ? (p0 * sA[e] + v0[e] * cA[e]) : (v0[e] * cA[e] - p0 * sA[e]);
                            o[4 + e] = odd ? (p1 * sB[e] + v1[e] * cB[e]) : (v1[e] * cB[e] - p1 * sB[e]); }
                        v4u w; w.x = pg8::cvt_pk_bf16(o[0], o[1]); w.y = pg8::cvt_pk_bf16(o[2], o[3]); w.z = pg8::cvt_pk_bf16(o[4], o[5]); w.w = pg8::cvt_pk_bf16(o[6], o[7]);
                        *(v4u*)(rowp + bj * 128) = w; } }
        }
    }
};

struct SchedBr {
    const char* omix; const char* wt; int G, c;
    __device__ __forceinline__ bool next(int i, Unit& u) const {
        int pm, pn; if (!pg8::static_tile(32, 8, G, c, i / 3, pm, pn)) return false;
        u.pm = pm; u.pn = pn; u.kind = i % 3; return true;
    }
    __device__ __forceinline__ void ptrs(const Unit& u, const char*& a, const char*& b, int& nt) const {
        const int koff = (u.kind == 0) ? 0 : (u.kind == 1) ? 768 : 1792; nt = (u.kind == 1) ? 16 : 12;
        a = omix + ((size_t)u.pm * 256 * MIXW + koff) * 2; b = wt + ((size_t)u.pn * 256 * MIXW + koff) * 2;
    }
};
__device__ __forceinline__ float sigmoidf_(float x) { return __builtin_amdgcn_rcpf(1.0f + __builtin_amdgcn_exp2f(-x * LOG2E)); }
struct EpiBr {
    static constexpr bool PERM = true;
    const bf16* u; float* mpart; bf16* merged;
    __device__ __forceinline__ void operator()(const f32x4 (&acc)[2][2][4][2], const Unit& un, int wr, int wc, int fr, int fq) const {
        asm volatile("" : "+v"(fr), "+v"(fq));
        const int r0 = wr * 64 + fr, c0 = wc * 32 + 8 * fq;
#pragma unroll
        for (int ai = 0; ai < 2; ++ai)
#pragma unroll
            for (int m = 0; m < 4; ++m) { const size_t row = (size_t)(un.pm * 256 + r0 + ai * 128 + m * 16);
#pragma unroll
                for (int bj = 0; bj < 2; ++bj) { const int col = un.pn * 256 + c0 + bj * 128;
                    const v4u gw = *(const v4u*)(u + row * INW + U_SA + un.kind * DM + col);
                    const f32x4 v0 = acc[ai][bj][m][0], v1 = acc[ai][bj][m][1];
                    f32x4 o0, o1;
                    o0[0] = sigmoidf_(bflo(gw.x)) * v0[0]; o0[1] = sigmoidf_(bfhi(gw.x)) * v0[1]; o0[2] = sigmoidf_(bflo(gw.y)) * v0[2]; o0[3] = sigmoidf_(bfhi(gw.y)) * v0[3];
                    o1[0] = sigmoidf_(bflo(gw.z)) * v1[0]; o1[1] = sigmoidf_(bfhi(gw.z)) * v1[1]; o1[2] = sigmoidf_(bflo(gw.w)) * v1[2]; o1[3] = sigmoidf_(bfhi(gw.w)) * v1[3];
                    float* pp = mpart + row * DM + col;
                    if (un.kind > 0) { o0 += *(const f32x4*)pp; o1 += *(const f32x4*)(pp + 4); }
                    if (un.kind < 2) { *(f32x4*)pp = o0; *(f32x4*)(pp + 4) = o1; }
                    else { v4u w; w.x = pg8::cvt_pk_bf16(o0[0], o0[1]); w.y = pg8::cvt_pk_bf16(o0[2], o0[3]); w.z = pg8::cvt_pk_bf16(o1[0], o1[1]); w.w = pg8::cvt_pk_bf16(o1[2], o1[3]);
                        *(v4u*)(merged + row * DM + col) = w; } } }
    }
};

struct SchedPlain {
    const char* A; const char* Bt; int nN, ld, nt, G, c;
    __device__ __forceinline__ bool next(int i, Unit& u) const { int pm, pn; if (!pg8::static_tile(32, nN, G, c, i, pm, pn)) return false; u.pm = pm; u.pn = pn; u.kind = 0; return true; }
    __device__ __forceinline__ void ptrs(const Unit& u, const char*& a, const char*& b, int& nt_) const { nt_ = nt; a = A + (size_t)u.pm * 256 * ld * 2; b = Bt + (size_t)u.pn * 256 * ld * 2; }
};
struct EpiResid {
    static constexpr bool PERM = false;
    const float* xin; float* xout;
    __device__ __forceinline__ void operator()(const f32x4 (&acc)[2][2][4][2], const Unit& un, int wr, int wc, int fr, int fq) const {
        asm volatile("" : "+v"(fr), "+v"(fq));
        const int r0 = un.pm * 256 + wr * 64 + fr, c0 = un.pn * 256 + wc * 32 + 4 * fq;
#pragma unroll
        for (int ai = 0; ai < 2; ++ai)
#pragma unroll
            for (int m = 0; m < 4; ++m) { const size_t off = (size_t)(r0 + ai * 128 + m * 16) * DM + c0;
#pragma unroll
                for (int bj = 0; bj < 2; ++bj)
#pragma unroll
                    for (int n = 0; n < 2; ++n) { const f32x4 b = *(const f32x4*)(xin + off + bj * 128 + n * 16); *(f32x4*)(xout + off + bj * 128 + n * 16) = b + acc[ai][bj][m][n]; } }
    }
};
struct EpiRelu2 {
    static constexpr bool PERM = true;
    bf16* h;
    __device__ __forceinline__ void operator()(const f32x4 (&acc)[2][2][4][2], const Unit& un, int wr, int wc, int fr, int fq) const {
        asm volatile("" : "+v"(fr), "+v"(fq));
        const int r0 = un.pm * 256 + wr * 64 + fr, c0 = un.pn * 256 + wc * 32 + 8 * fq;
#pragma unroll
        for (int ai = 0; ai < 2; ++ai)
#pragma unroll
            for (int m = 0; m < 4; ++m) { bf16* rowp = h + (size_t)(r0 + ai * 128 + m * 16) * FF + c0;
#pragma unroll
                for (int bj = 0; bj < 2; ++bj) { f32x4 v0 = acc[ai][bj][m][0], v1 = acc[ai][bj][m][1];
#pragma unroll
                    for (int e = 0; e < 4; ++e) { const float a = v0[e] > 0.f ? v0[e] : 0.f, b = v1[e] > 0.f ? v1[e] : 0.f; v0[e] = a * a; v1[e] = b * b; }
                    v4u w; w.x = pg8::cvt_pk_bf16(v0[0], v0[1]); w.y = pg8::cvt_pk_bf16(v0[2], v0[3]); w.z = pg8::cvt_pk_bf16(v1[0], v1[1]); w.w = pg8::cvt_pk_bf16(v1[2], v1[3]);
                    *(v4u*)(rowp + bj * 128) = w; } }
    }
};
struct SchedCross {
    const char* xn; const char* wq; const char* mn; const char* wkv; int G, c;
    __device__ __forceinline__ bool next(int i, Unit& u) const {
        const int L = i * G + c; if (L >= 72) return false;
        if (L < 64) { u.pm = L >> 1; u.pn = L & 1; u.kind = 0; }
        else if (L < 68) { u.pm = (L - 64) & 1; u.pn = (L - 64) >> 1; u.kind = 1; }
        else { u.pm = (L - 68) >> 1; u.pn = (L - 68) & 1; u.kind = 2; }
        return true;
    }
    __device__ __forceinline__ void ptrs(const Unit& u, const char*& a, const char*& b, int& nt) const {
        nt = DM / 64;
        if (u.kind == 0) { a = xn + (size_t)u.pm * TSTEP_DM; b = wq + (size_t)u.pn * TSTEP_DM; }
        else if (u.kind == 1) { a = mn + (size_t)u.pm * TSTEP_DM; b = wkv + (size_t)u.pn * TSTEP_DM; }
        else { a = wkv + (size_t)(2 + u.pm) * TSTEP_DM; b = mn + (size_t)u.pn * TSTEP_DM; }
    }
};
struct EpiCross {
    static constexpr bool PERM = true;
    bf16* qx; bf16* kx; bf16* vxT;
    __device__ __forceinline__ void operator()(const f32x4 (&acc)[2][2][4][2], const Unit& un, int wr, int wc, int fr, int fq) const {
        asm volatile("" : "+v"(fr), "+v"(fq));
        bf16* base = (un.kind == 0) ? qx : (un.kind == 1) ? kx : vxT;
        const int r0 = un.pm * 256 + wr * 64 + fr, c0 = un.pn * 256 + wc * 32 + 8 * fq;
#pragma unroll
        for (int ai = 0; ai < 2; ++ai)
#pragma unroll
            for (int m = 0; m < 4; ++m) { bf16* rowp = base + (size_t)(r0 + ai * 128 + m * 16) * CRW + c0;
#pragma unroll
                for (int bj = 0; bj < 2; ++bj) { const f32x4 v0 = acc[ai][bj][m][0], v1 = acc[ai][bj][m][1];
                    v4u w; w.x = pg8::cvt_pk_bf16(v0[0], v0[1]); w.y = pg8::cvt_pk_bf16(v0[2], v0[3]); w.z = pg8::cvt_pk_bf16(v1[0], v1[1]); w.w = pg8::cvt_pk_bf16(v1[2], v1[3]);
                    *(v4u*)(rowp + bj * 128) = w; } }
    }
};

__device__ __forceinline__ unsigned off_b(unsigned row, unsigned ch) { return 256u * row + 16u * (ch ^ (((row & 3) << 2) | ((row >> 2) & 3))); }
__device__ __forceinline__ unsigned tr_read_addr_16(unsigned lane, unsigned c, unsigned t) {
    const unsigned g = lane >> 4, q = (lane & 15) >> 2, p = lane & 3;
    return off_b(8 * g + 4 * t + q, 2 * c + (p >> 1)) + 8 * (p & 1);
}
__device__ __forceinline__ s16x4 tr_read(LAS unsigned char* p) { return __builtin_amdgcn_ds_read_tr16_b64_v4i16((LAS s16x4*)p); }

struct AttnState { f32x4 o[8]; float m, l; };
__device__ __forceinline__ void attn_softmax_step(AttnState& A, float (&x)[8], unsigned vmask, bf16x8& bp) {
    float mx = -1e30f;
#pragma unroll
    for (int e = 0; e < 8; ++e) { x[e] = ((vmask >> e) & 1u) ? x[e] : -1e30f; mx = fmaxf(mx, x[e]); }
    mx = fmaxf(mx, __shfl_xor(mx, 16)); mx = fmaxf(mx, __shfl_xor(mx, 32));
    const float mn = fmaxf(A.m, mx), alpha = __builtin_amdgcn_exp2f(A.m - mn);
    float p[8], sum = 0.f;
#pragma unroll
    for (int e = 0; e < 8; ++e) { p[e] = ((vmask >> e) & 1u) ? __builtin_amdgcn_exp2f(x[e] - mn) : 0.f; sum += p[e]; }
    sum += __shfl_xor(sum, 16); sum += __shfl_xor(sum, 32);
    A.l = A.l * alpha + sum; A.m = mn;
#pragma unroll
    for (int c = 0; c < 8; ++c) A.o[c] *= alpha;
    bp = pack8(p);
}
template <class RowFn>
__device__ __forceinline__ void attn_pv_step(AttnState& A, LAS unsigned char* vt, int lane, const bf16x8 bp, const RowFn& rowptr) {
    bf16x8 vv[8];
#pragma unroll
    for (int i = 0; i < 8; ++i) { const int row = (lane >> 4) + 4 * i; vv[i] = ldg8(rowptr(row) + (lane & 15) * 8); }
#pragma unroll
    for (int i = 0; i < 8; ++i) { const int row = (lane >> 4) + 4 * i; *(LAS bf16x8*)(vt + off_b(row, lane & 15)) = vv[i]; }
    LDS_WAIT(); __builtin_amdgcn_wave_barrier();
#pragma unroll
    for (int c = 0; c < 8; ++c) {
        const s16x4 t0 = tr_read(vt + tr_read_addr_16(lane, c, 0)), t1 = tr_read(vt + tr_read_addr_16(lane, c, 1));
        bf16x8 a; a[0] = t0[0]; a[1] = t0[1]; a[2] = t0[2]; a[3] = t0[3]; a[4] = t1[0]; a[5] = t1[1]; a[6] = t1[2]; a[7] = t1[3];
        A.o[c] = MFMA16(a, bp, A.o[c]);
    }
    LDS_WAIT(); __builtin_amdgcn_wave_barrier();
}

__device__ __forceinline__ int t5_bucket_dev(int rel) {
    const int n = rel < 0 ? -rel : rel; int b;
    if (n < 8) b = n; else b = 8 + (n >= 15) + (n >= 27) + (n >= 50) + (n >= 91) + (n >= 166) + (n >= 305) + (n >= 559);
    return b + (rel > 0 ? 16 : 0);
}

__device__ __forceinline__ void load_mixer_tables(Frame& F, const float* rpb_l, const float* t5_bias) {
    LAS float* rpb2 = (LAS float*)(F.lds + LDS_RPB); LAS float* t5b2 = (LAS float*)(F.lds + LDS_T5);
    for (int i = (F.wave * 64 + lane_id()); i < 6 * 15 * 31; i += NWAVES * 64) rpb2[i] = rpb_l[i] * LOG2E;
    for (int i = (F.wave * 64 + lane_id()); i < 6 * 3 * 129; i += NWAVES * 64) { const int h = i / 387, r = i % 387, gv = r / 129, jj = r % 129; const int d = (gv == 0) ? 1 : (gv == 1) ? 4 : 16;
        t5b2[i] = t5_bias[t5_bucket_dev(d * (jj - 64)) * 6 + h] * LOG2E; }
    __syncthreads();
}

__device__ __forceinline__ void na_tasks(Frame& F, const bf16* u, bf16* omix) {
    const LAS float* rpb2 = (const LAS float*)(F.lds + LDS_RPB);
    LAS unsigned char* vt = F.lds + F.wave * 8192;
    int lane = lane_id(); asm volatile("" : "+v"(lane)); const int g = lane >> 4, li = lane & 15;
    for (int task = F.gw; task < NB * 6 * 64 * 4; task += F.ngw) {
        const int j = task & 3, r = (task >> 2) & 63, h = (task >> 8) % 6, b = task / 1536;
        const int qi = 16 * j + li;
        const size_t tq = (size_t)b * SEQ + r * 64 + qi;
        const int r0 = min(max(r - 4, 0), 56), cl = min(max(16 * j - 8, 0), 32), c0q = min(max(qi - 8, 0), 48);
        bf16x8 bq[4];
#pragma unroll
        for (int ks = 0; ks < 4; ++ks) bq[ks] = ldg8(u + tq * INW + U_QA + h * 128 + 32 * ks + 8 * g);
        AttnState A;
#pragma unroll
        for (int c = 0; c < 8; ++c) A.o[c] = (f32x4){0.f, 0.f, 0.f, 0.f};
        A.m = -1e30f; A.l = 0.f;
        const int sig0 = 8 * (li >> 2) + (li & 3);
        for (int s = 0; s < 8; ++s) {
            const int kr = r0 + s;
            const size_t tk0 = (size_t)b * SEQ + kr * 64 + cl;
            f32x4 st0 = (f32x4){0.f, 0.f, 0.f, 0.f}, st1 = st0;
            const bf16* k0p = u + (tk0 + sig0) * INW + U_KA + h * 128 + 8 * g; const bf16* k1p = k0p + (size_t)4 * INW;
#pragma unroll
            for (int ks = 0; ks < 4; ++ks) { const bf16x8 a0 = ldg8(k0p + 32 * ks), a1 = ldg8(k1p + 32 * ks); st0 = MFMA16(a0, bq[ks], st0); st1 = MFMA16(a1, bq[ks], st1); }
            float x[8]; unsigned vmask = 0u;
#pragma unroll
            for (int e = 0; e < 8; ++e) { const int kc = cl + 8 * g + e; const bool valid = (kc >= c0q) && (kc < c0q + 16);
                const int bi = valid ? ((h * 15 + (kr - r + 7)) * 31 + (kc - qi + 15)) : 0;
                x[e] = ((e < 4) ? st0[e & 3] : st1[e & 3]) + rpb2[bi]; vmask |= valid ? (1u << e) : 0u; }
            bf16x8 bp; attn_softmax_step(A, x, vmask, bp);
            const bf16* vbase = u + tk0 * INW + U_VA + h * 128;
            attn_pv_step(A, vt, lane, bp, [&](int row) { return vbase + (size_t)row * INW; });
        }
        const float inv = 1.0f / A.l;
        bf16* op = omix + tq * MIXW + h * 128 + 4 * g;
#pragma unroll
        for (int c = 0; c < 8; ++c) { v2u w; w.x = pk2(A.o[c][0] * inv, A.o[c][1] * inv); w.y = pk2(A.o[c][2] * inv, A.o[c][3] * inv); *(v2u*)(op + 16 * c) = w; }
    }
}

template <int VIEW>
__device__ __forceinline__ void dil_tasks(Frame& F, const bf16* u, bf16* omix, float* po, float* pl) {
    constexpr int DD = (VIEW == 0) ? 1 : (VIEW == 1) ? 4 : 16, DL = SEQ / DD, GPC = DL / 16;
    const LAS float* t5b2 = (const LAS float*)(F.lds + LDS_T5);
    LAS unsigned char* vt = F.lds + F.wave * 8192;
    int lane = lane_id(); asm volatile("" : "+v"(lane)); const int g = lane >> 4, li = lane & 15;
    for (int task = F.gw; task < NB * 6 * 256; task += F.ngw) {
        const int grp = task & 255, h = (task >> 8) % 6, b = task / 1536;
        const int rho = grp / GPC, p0 = 16 * (grp % GPC);
        const int qp = p0 + li;
        const size_t tb = (size_t)b * SEQ + rho;
        const size_t tq = tb + (size_t)DD * qp;
        bf16x8 bq[4];
#pragma unroll
        for (int ks = 0; ks < 4; ++ks) bq[ks] = ldg8(u + tq * INW + U_QC + h * 128 + 32 * ks + 8 * g);
        AttnState A;
#pragma unroll
        for (int c = 0; c < 8; ++c) A.o[c] = (f32x4){0.f, 0.f, 0.f, 0.f};
        A.m = -1e30f; A.l = 0.f;
        const int sig0 = 8 * (li >> 2) + (li & 3);
        const LAS float* bias = t5b2 + (h * 3 + VIEW) * 129;
        for (int s = 0; s < 5; ++s) {
            const int kp0 = p0 - 64 + 32 * s;
            const int ka = min(max(kp0 + sig0, 0), DL - 1), kb_ = min(max(kp0 + sig0 + 4, 0), DL - 1);
            const bf16* k0p = u + (tb + (size_t)DD * ka) * INW + U_KC + h * 128 + 8 * g; const bf16* k1p = u + (tb + (size_t)DD * kb_) * INW + U_KC + h * 128 + 8 * g;
            f32x4 st0 = (f32x4){0.f, 0.f, 0.f, 0.f}, st1 = st0;
#pragma unroll
            for (int ks = 0; ks < 4; ++ks) { const bf16x8 a0 = ldg8(k0p + 32 * ks), a1 = ldg8(k1p + 32 * ks); st0 = MFMA16(a0, bq[ks], st0); st1 = MFMA16(a1, bq[ks], st1); }
            float x[8]; unsigned vmask = 0u;
#pragma unroll
            for (int e = 0; e < 8; ++e) { const int kp = kp0 + 8 * g + e, dl = kp - qp; const bool valid = (kp >= 0) && (kp < DL) && (dl >= -64) && (dl <= 64);
                x[e] = ((e < 4) ? st0[e & 3] : st1[e & 3]) + bias[valid ? dl + 64 : 0]; vmask |= valid ? (1u << e) : 0u; }
            bf16x8 bp; attn_softmax_step(A, x, vmask, bp);
            const bf16* vbase = u + U_VC + h * 128;
            attn_pv_step(A, vt, lane, bp, [&](int row) { const int kp = min(max(kp0 + row, 0), DL - 1); return vbase + (tb + (size_t)DD * kp) * INW; });
        }
        const float inv = 1.0f / A.l, lse = A.m + __builtin_amdgcn_logf(A.l);
        if (VIEW != 0) {
            float* pp = po + ((size_t)(VIEW - 1) * MT + tq) * 768 + h * 128 + 4 * g;
#pragma unroll
            for (int c = 0; c < 8; ++c) *(f32x4*)(pp + 16 * c) = A.o[c] * inv;
            if (g == 0) pl[((size_t)(VIEW - 1) * MT + tq) * 8 + h] = lse;
        } else {
            const float l4 = pl[tq * 8 + h], l16 = pl[((size_t)MT + tq) * 8 + h];
            const float mx = fmaxf(lse, fmaxf(l4, l16));
            const float w1 = __builtin_amdgcn_exp2f(lse - mx), w4 = __builtin_amdgcn_exp2f(l4 - mx), w16 = __builtin_amdgcn_exp2f(l16 - mx);
            const float wi = 1.0f / (w1 + w4 + w16), a1 = w1 * wi * inv, a4 = w4 * wi, a16 = w16 * wi;
            const float* p4 = po + tq * 768 + h * 128 + 4 * g; const float* p16 = po + ((size_t)MT + tq) * 768 + h * 128 + 4 * g;
            bf16* op = omix + tq * MIXW + 1792 + h * 128 + 4 * g;
#pragma unroll
            for (int c = 0; c < 8; ++c) { const f32x4 v4 = *(const f32x4*)(p4 + 16 * c), v16 = *(const f32x4*)(p16 + 16 * c); const f32x4 o = A.o[c] * a1 + v4 * a4 + v16 * a16;
                v2u w; w.x = pk2(o[0], o[1]); w.y = pk2(o[2], o[3]); *(v2u*)(op + 16 * c) = w; }
        }
    }
}

__device__ __forceinline__ void cross_tasks(Frame& F, const bf16* qx, const bf16* kx, const bf16* vxT, bf16* ax) {
    int lane = lane_id(); asm volatile("" : "+v"(lane)); const int g = lane >> 4, li = lane & 15;
    for (int task = F.gw; task < NB * 4 * 256; task += F.ngw) {
        const int grp = task & 255, h = (task >> 8) & 3, b = task >> 10;
        const size_t tq = (size_t)b * SEQ + 16 * grp + li;
        bf16x8 bq[4];
#pragma unroll
        for (int ks = 0; ks < 4; ++ks) bq[ks] = ldg8(qx + tq * CRW + h * 128 + 32 * ks + 8 * g);
        AttnState A;
#pragma unroll
        for (int c = 0; c < 8; ++c) A.o[c] = (f32x4){0.f, 0.f, 0.f, 0.f};
        A.m = -1e30f; A.l = 0.f;
        const int sig0 = 8 * (li >> 2) + (li & 3);
        for (int s = 0; s < 8; ++s) {
            const size_t tk0 = (size_t)b * MEML + 32 * s;
            const bf16* k0p = kx + (tk0 + sig0) * CRW + h * 128 + 8 * g; const bf16* k1p = k0p + (size_t)4 * CRW;
            f32x4 st0 = (f32x4){0.f, 0.f, 0.f, 0.f}, st1 = st0;
#pragma unroll
            for (int ks = 0; ks < 4; ++ks) { const bf16x8 a0 = ldg8(k0p + 32 * ks), a1 = ldg8(k1p + 32 * ks); st0 = MFMA16(a0, bq[ks], st0); st1 = MFMA16(a1, bq[ks], st1); }
            float x[8];
#pragma unroll
            for (int e = 0; e < 8; ++e) x[e] = (e < 4) ? st0[e & 3] : st1[e & 3];
            bf16x8 bp; attn_softmax_step(A, x, 0xffu, bp);
#pragma unroll
            for (int c = 0; c < 8; ++c) { const bf16x8 a = ldg8(vxT + (size_t)(h * 128 + 16 * c + li) * MEMT + tk0 + 8 * g); A.o[c] = MFMA16(a, bp, A.o[c]); }
        }
        const float inv = 1.0f / A.l;
        bf16* op = ax + tq * CRW + h * 128 + 4 * g;
#pragma unroll
        for (int c = 0; c < 8; ++c) { v2u w; w.x = pk2(A.o[c][0] * inv, A.o[c][1] * inv); w.y = pk2(A.o[c][2] * inv, A.o[c][3] * inv); *(v2u*)(op + 16 * c) = w; }
    }
}

__device__ __forceinline__ void scan_tasks(Frame& F, const bf16* kbT, const bf16* vbT, bf16* states, const float* decay_l) {
    int lane = lane_id(); asm volatile("" : "+v"(lane)); const int g = lane >> 4, li = lane & 15;
    for (int task = F.gw; task < 2048; task += F.ngw) {
        const int c = task & 15, a = (task >> 4) & 7, h = (task >> 7) & 3, b = (task >> 9) & 1, dir = task >> 10;
        const float lg2 = -__expf(decay_l[dir * 4 + h]) * LOG2E;
        const float gc = __builtin_amdgcn_exp2f(128.f * lg2);
        float w[4][8];
#pragma unroll
        for (int ks = 0; ks < 4; ++ks)
#pragma unroll
            for (int e = 0; e < 8; ++e) { const int jt = 32 * ks + 8 * g + e; w[ks][e] = __builtin_amdgcn_exp2f((dir == 0 ? (float)(127 - jt) : (float)jt) * lg2); }
        const bf16* kp = kbT + (size_t)(h * 128 + 16 * a + li) * MT + (size_t)b * SEQ + 8 * g;
        const bf16* vp = vbT + (size_t)(h * 256 + 16 * c + li) * MT + (size_t)b * SEQ + 8 * g;
        bf16* sp = states + ((size_t)((dir * 2 + b) * 4 + h) * 32) * (256 * 128) + (size_t)(16 * c + li) * 128 + 16 * a + 4 * g;
        f32x4 acc = (f32x4){0.f, 0.f, 0.f, 0.f};
        for (int cc = 0; cc < 32; ++cc) {
            const int ch = (dir == 0) ? cc : 31 - cc;
            { v2u wv; wv.x = pk2(acc[0], acc[1]); wv.y = pk2(acc[2], acc[3]); *(v2u*)(sp + (size_t)ch * (256 * 128)) = wv; }
            acc *= gc;
#pragma unroll
            for (int ks = 0; ks < 4; ++ks) {
                const bf16x8 ka = ldg8(kp + ch * 128 + 32 * ks); const v4u vr = __builtin_bit_cast(v4u, ldg8(vp + ch * 128 + 32 * ks));
                float vw[8]; vw[0] = bflo(vr.x) * w[ks][0]; vw[1] = bfhi(vr.x) * w[ks][1]; vw[2] = bflo(vr.y) * w[ks][2]; vw[3] = bfhi(vr.y) * w[ks][3];
                vw[4] = bflo(vr.z) * w[ks][4]; vw[5] = bfhi(vr.z) * w[ks][5]; vw[6] = bflo(vr.w) * w[ks][6]; vw[7] = bfhi(vr.w) * w[ks][7];
                acc = MFMA16(ka, pack8(vw), acc);
            }
        }
    }
}

__device__ __forceinline__ void retout_tasks(Frame& F, const bf16* u, const bf16* vbT, const bf16* states, const float* decay_l, bf16* omix) {
    int lane = lane_id(); asm volatile("" : "+v"(lane)); const int g = lane >> 4, li = lane & 15;
    for (int task = F.gw; task < 2048; task += F.ngw) {
        const int qg = task & 7, ch = (task >> 3) & 31, h = (task >> 8) & 3, b = task >> 10;
        const float lf = -__expf(decay_l[h]) * LOG2E, lb = -__expf(decay_l[4 + h]) * LOG2E;
        const int iq = 16 * qg + li;
        const size_t t0 = (size_t)b * SEQ + ch * 128;
        bf16x8 bq[4];
#pragma unroll
        for (int ks = 0; ks < 4; ++ks) bq[ks] = ldg8(u + (t0 + iq) * INW + U_QB + h * 128 + 32 * ks + 8 * g);
        f32x4 tot[16], tmp[16];
        const bf16* sf = states + ((size_t)((0 * 2 + b) * 4 + h) * 32 + ch) * (256 * 128) + (size_t)li * 128 + 8 * g;
        const bf16* sb = states + ((size_t)((1 * 2 + b) * 4 + h) * 32 + ch) * (256 * 128) + (size_t)li * 128 + 8 * g;
#pragma unroll
        for (int c = 0; c < 16; ++c) { f32x4 t = (f32x4){0.f, 0.f, 0.f, 0.f};
#pragma unroll
            for (int ks = 0; ks < 4; ++ks) t = MFMA16(ldg8(sf + (size_t)c * 16 * 128 + 32 * ks), bq[ks], t);
            tot[c] = t * __builtin_amdgcn_exp2f((float)(iq + 1) * lf); }
#pragma unroll
        for (int c = 0; c < 16; ++c) { f32x4 t = (f32x4){0.f, 0.f, 0.f, 0.f};
#pragma unroll
            for (int ks = 0; ks < 4; ++ks) t = MFMA16(ldg8(sb + (size_t)c * 16 * 128 + 32 * ks), bq[ks], t);
            tot[c] += t * __builtin_amdgcn_exp2f((float)(128 - iq) * lb); }
        const int sig0 = 8 * (li >> 2) + (li & 3);
        for (int s = 0; s < 4; ++s) {
            const bf16* k0p = u + (t0 + 32 * s + sig0) * INW + U_KB + h * 128 + 8 * g; const bf16* k1p = k0p + (size_t)4 * INW;
            f32x4 st0 = (f32x4){0.f, 0.f, 0.f, 0.f}, st1 = st0;
#pragma unroll
            for (int ks = 0; ks < 4; ++ks) { const bf16x8 a0 = ldg8(k0p + 32 * ks), a1 = ldg8(k1p + 32 * ks); st0 = MFMA16(a0, bq[ks], st0); st1 = MFMA16(a1, bq[ks], st1); }
            float p[8];
#pragma unroll
            for (int e = 0; e < 8; ++e) { const int jk = 32 * s + 8 * g + e, df = iq - jk;
                const float dm = (df >= 0) ? __builtin_amdgcn_exp2f((float)df * lf) : __builtin_amdgcn_exp2f((float)(-df) * lb);
                p[e] = ((e < 4) ? st0[e & 3] : st1[e & 3]) * dm; }
            const bf16x8 bp = pack8(p);
            const bf16* vp = vbT + (size_t)(h * 256 + li) * MT + t0 + 32 * s + 8 * g;
#pragma unroll
            for (int c = 0; c < 16; ++c) tot[c] = MFMA16(ldg8(vp + (size_t)c * 16 * MT), bp, tot[c]);
        }
        (void)tmp;
        float s1 = 0.f;
#pragma unroll
        for (int c = 0; c < 16; ++c) s1 += (tot[c][0] + tot[c][1]) + (tot[c][2] + tot[c][3]);
        s1 += __shfl_xor(s1, 16); s1 += __shfl_xor(s1, 32);
        const float mu = s1 * (1.f / 256.f); float s2 = 0.f;
#pragma unroll
        for (int c = 0; c < 16; ++c) { const f32x4 d = tot[c] - mu; s2 += (d[0] * d[0] + d[1] * d[1]) + (d[2] * d[2] + d[3] * d[3]); }
        s2 += __shfl_xor(s2, 16); s2 += __shfl_xor(s2, 32);
        const float rstd = 1.0f / sqrtf(s2 * (1.f / 256.f) + EPSF);
        const bf16* gp = u + (t0 + iq) * INW + U_GR + h * 256 + 4 * g;
        bf16* op = omix + (t0 + iq) * MIXW + 768 + h * 256 + 4 * g;
#pragma unroll
        for (int c = 0; c < 16; ++c) { const v2u gv = *(const v2u*)(gp + 16 * c); float gt[4] = {bflo(gv.x), bfhi(gv.x), bflo(gv.y), bfhi(gv.y)}; float o[4];
#pragma unroll
            for (int e = 0; e < 4; ++e) { const float sg = gt[e] * sigmoidf_(gt[e]); o[e] = sg * (tot[c][e] - mu) * rstd; }
            v2u w; w.x = pk2(o[0], o[1]); w.y = pk2(o[2], o[3]); *(v2u*)(op + 16 * c) = w; }
    }
}

__device__ __forceinline__ unsigned char* ws_opq(unsigned char* ws, size_t off) { asm volatile("" : "+s"(ws)); return ws + off; }
__device__ __forceinline__ const float* in_opq(const float* p) { asm volatile("" : "+s"(p)); return p; }
struct Args { const float* in[18]; float* out; unsigned char* ws; int ph_lo, ph_hi; };
constexpr int PH_PER_LAYER = 13, N_PHASES = 1 + DEPTH * PH_PER_LAYER + 1;

__global__ void __launch_bounds__(NWAVES * 64, 2) enc_fwd(Args args) {
    extern __shared__ __attribute__((aligned(16))) unsigned char lds[];
    Frame F;
    F.lds = (LAS unsigned char*)lds;
    F.wave = __builtin_amdgcn_readfirstlane((int)threadIdx.x >> 6);
    F.G = gridDim.x; { const int bx = blockIdx.x; F.vcu = (F.G % 8 == 0) ? (bx % 8) * (F.G / 8) + bx / 8 : bx; }
    F.gw = F.vcu * NWAVES + F.wave; F.ngw = F.G * NWAVES;
    volatile LAS unsigned* MISC = (volatile LAS unsigned*)(F.lds + MISC_OFF);
    for (int i = (F.wave * 64 + lane_id()); i < (LDS_BYTES - LDSCTL_OFF) / 4; i += NWAVES * 64) ((LAS unsigned*)(F.lds + LDSCTL_OFF))[i] = 0u;
    __syncthreads();
    gu32* ctl = (gu32*)(args.ws + WS_CTL);
    XcdBarrier bar; bar.bar = (unsigned*)ctl + CW_BAR; bar.x = 0; bar.st = nullptr;
    if (!MK_LAUNCH_PER_PHASE) bar = xcd_barrier_post((unsigned*)ctl + CW_BAR, MISC + 8, F.wave == 0 && lane_id() == 0);
#define GRID_BAR() do { if (!MK_LAUNCH_PER_PHASE) xcd_barrier(bar, F.wave == 0 && lane_id() == 0); } while (0)
    const int lo = args.ph_lo, hi = args.ph_hi;
#ifndef PHMASK
#define PHMASK 0xffffu
#endif
#define PHK(k) ((k) == 0 ? 0 : (k) == N_PHASES - 1 ? 14 : 1 + ((k) - 1) % PH_PER_LAYER)
#define IN(k) (lo <= (k) && (k) < hi)
#define INP(k, kk) (((PHMASK >> (kk)) & 1u) && IN(k))
#define SEAM(k) do { if (IN((k) + 1)) GRID_BAR(); } while (0)

#define WSP(T, off) ((T*)ws_opq(args.ws, (off)))
#define INP_(k) in_opq(args.in[(k)])
#define x_in INP_(0)
#define mem INP_(1)
#define t5_bias INP_(2)
#define norm_mix_g INP_(3)
#define w_in INP_(4)
#define na_rpb INP_(5)
#define ret_decay INP_(6)
#define w_branch INP_(7)
#define w_out INP_(8)
#define norm_cross_g INP_(9)
#define norm_mem_g INP_(10)
#define w_cq INP_(11)
#define w_ckv INP_(12)
#define w_co INP_(13)
#define norm_mlp_g INP_(14)
#define w_mlp1 INP_(15)
#define w_mlp2 INP_(16)
#define final_norm_g INP_(17)
#define rope WSP(float, WS_ROPE)
#define Wt_in WSP(bf16, WS_WIN)
#define Wt_br WSP(bf16, WS_WBR)
#define Wt_out WSP(bf16, WS_WOUT)
#define Wt_cq WSP(bf16, WS_WCQ)
#define Wt_ckv WSP(bf16, WS_WCKV)
#define Wt_co WSP(bf16, WS_WCO)
#define Wt_1 WSP(bf16, WS_W1)
#define Wt_2 WSP(bf16, WS_W2)
#define MN WSP(bf16, WS_MN)
#define X WSP(float, WS_X)
#define XN WSP(bf16, WS_XN)
#define U WSP(bf16, WS_U)
#define H WSP(bf16, WS_H)
#define VBT WSP(bf16, WS_VBT)
#define KBT WSP(bf16, WS_KBT)
#define ST WSP(bf16, WS_ST)
#define OMIX WSP(bf16, WS_OMIX)
#define PO WSP(float, WS_PO)
#define PL WSP(float, WS_PL)
#define MPART WSP(float, WS_MPART)
#define MERGED WSP(bf16, WS_MERGED)
#define QX WSP(bf16, WS_QX)
#define KX WSP(bf16, WS_KX)
#define VXT WSP(bf16, WS_VXT)
#define AX WSP(bf16, WS_AX)

    if (INP(0, 0)) {
        LAS float* scr = (LAS float*)(F.lds + RING_OFF + F.wave * 16384);
        constexpr int I_IN = (DM / 64) * (INW / 32), I_BR = (MIXW / 64) * (DM / 32), I_OUT = (DM / 64) * (DM / 32), I_CQ = (DM / 64) * (CRW / 32), I_CKV = (DM / 64) * (2 * CRW / 32),
                      I_CO = (CRW / 64) * (DM / 32), I_1 = (DM / 64) * (FF / 32), I_2 = (FF / 64) * (DM / 32);
        constexpr int I_LAYER = I_IN + I_BR + I_OUT + I_CQ + I_CKV + I_CO + I_1 + I_2;
        for (int it = F.gw; it < DEPTH * I_LAYER; it += F.ngw) {
            const int l = it / I_LAYER; int r = it % I_LAYER;
            if (r < I_IN) { p0_transpose_item<1>(w_in + (size_t)l * DM * INW, DM, INW, Wt_in + (size_t)l * INW * DM, scr, r, lane_id()); continue; } r -= I_IN;
            if (r < I_BR) { p0_transpose_item<0>(w_branch + (size_t)l * MIXW * DM, MIXW, DM, Wt_br + (size_t)l * DM * MIXW, scr, r, lane_id()); continue; } r -= I_BR;
            if (r < I_OUT) { p0_transpose_item<0>(w_out + (size_t)l * DM * DM, DM, DM, Wt_out + (size_t)l * DM * DM, scr, r, lane_id()); continue; } r -= I_OUT;
            if (r < I_CQ) { p0_transpose_item<2>(w_cq + (size_t)l * DM * CRW, DM, CRW, Wt_cq + (size_t)l * CRW * DM, scr, r, lane_id()); continue; } r -= I_CQ;
            if (r < I_CKV) { p0_transpose_item<0>(w_ckv + (size_t)l * DM * 2 * CRW, DM, 2 * CRW, Wt_ckv + (size_t)l * 2 * CRW * DM, scr, r, lane_id()); continue; } r -= I_CKV;
            if (r < I_CO) { p0_transpose_item<0>(w_co + (size_t)l * CRW * DM, CRW, DM, Wt_co + (size_t)l * DM * CRW, scr, r, lane_id()); continue; } r -= I_CO;
            if (r < I_1) { p0_transpose_item<0>(w_mlp1 + (size_t)l * DM * FF, DM, FF, Wt_1 + (size_t)l * FF * DM, scr, r, lane_id()); continue; } r -= I_1;
            p0_transpose_item<0>(w_mlp2 + (size_t)l * FF * DM, FF, DM, Wt_2 + (size_t)l * DM * FF, scr, r, lane_id());
        }
        float* ropep = rope;
        for (int e = F.gw * 64 + lane_id(); e < SEQ * 64; e += F.ngw * 64) { const int t = e >> 6, i = e & 63; float s, c; sincos_f32((float)t * rope_inv_freq(i), s, c);
            ropep[e] = c; ropep[SEQ * 64 + e] = s; ropep[2 * SEQ * 64 + (size_t)i * SEQ + t] = c; ropep[3 * SEQ * 64 + (size_t)i * SEQ + t] = s; }
        for (int m = F.gw; m < DEPTH * MEMT; m += F.ngw) { const int l = m / MEMT, r = m % MEMT; rms_row_to_bf16(mem + (size_t)r * DM, norm_mem_g + (size_t)l * DM, MN + (size_t)m * DM, lane_id()); }
        SEAM(0);
    }

    for (int l = 0; l < DEPTH; ++l) {
        const int pb = 1 + l * PH_PER_LAYER;
        if (INP(pb + 0, 1)) {
            for (int m = F.gw; m < MT; m += F.ngw) rms_row_to_bf16(((l == 0) ? x_in : (const float*)X) + (size_t)m * DM, norm_mix_g + (size_t)l * DM, XN + (size_t)m * DM, lane_id());
            SEAM(pb + 0);
        }
        if (INP(pb + 1, 2)) {
            SchedIn S{(const char*)XN, (const char*)(Wt_in + (size_t)l * INW * DM), F.G, (int)blockIdx.x};
            EpiIn E{U, VBT, KBT, rope};
            pg8::gemm_phase<EpiIn, SchedIn, PG8_ALIGN, PG8_SP2>(F.lds + RING_OFF, F.wave, DM, S, E);
            SEAM(pb + 1);
        }
        if (INP(pb + 2, 3)) {
            load_mixer_tables(F, na_rpb + (size_t)l * 6 * 15 * 31, t5_bias);
            scan_tasks(F, KBT, VBT, ST, ret_decay + l * 8);
            na_tasks(F, U, OMIX);
            dil_tasks<1>(F, U, OMIX, PO, PL);
            dil_tasks<2>(F, U, OMIX, PO, PL);
            SEAM(pb + 2);
        }
        if (INP(pb + 3, 4)) {
            if (MK_LAUNCH_PER_PHASE) load_mixer_tables(F, na_rpb + (size_t)l * 6 * 15 * 31, t5_bias);
            retout_tasks(F, U, VBT, ST, ret_decay + l * 8, OMIX);
            dil_tasks<0>(F, U, OMIX, PO, PL);
            SEAM(pb + 3);
        }
        if (INP(pb + 4, 5)) {
            __syncthreads();
            SchedBr S{(const char*)OMIX, (const char*)(Wt_br + (size_t)l * DM * MIXW), F.G, (int)blockIdx.x};
            EpiBr E{U, MPART, MERGED};
            pg8::gemm_phase<EpiBr, SchedBr, PG8_ALIGN, PG8_SP2>(F.lds + RING_OFF, F.wave, MIXW, S, E);
            SEAM(pb + 4);
        }
        if (INP(pb + 5, 6)) {
            SchedPlain S{(const char*)MERGED, (const char*)(Wt_out + (size_t)l * DM * DM), 8, DM, DM / 64, F.G, (int)blockIdx.x};
            EpiResid E{(l == 0) ? x_in : (const float*)X, X};
            pg8::gemm_phase<EpiResid, SchedPlain, PG8_ALIGN, PG8_SP2>(F.lds + RING_OFF, F.wave, DM, S, E);
            SEAM(pb + 5);
        }
        if (INP(pb + 6, 7)) {
            for (int m = F.gw; m < MT; m += F.ngw) rms_row_to_bf16(X + (size_t)m * DM, norm_cross_g + (size_t)l * DM, XN + (size_t)m * DM, lane_id());
            SEAM(pb + 6);
        }
        if (INP(pb + 7, 8)) {
            SchedCross S{(const char*)XN, (const char*)(Wt_cq + (size_t)l * CRW * DM), (const char*)(MN + (size_t)l * MEMT * DM), (const char*)(Wt_ckv + (size_t)l * 2 * CRW * DM), F.G, (int)blockIdx.x};
            EpiCross E{QX, KX, VXT};
            pg8::gemm_phase<EpiCross, SchedCross, PG8_ALIGN, PG8_SP2>(F.lds + RING_OFF, F.wave, DM, S, E);
            SEAM(pb + 7);
        }
        if (INP(pb + 8, 9)) {
            cross_tasks(F, QX, KX, VXT, AX);
            SEAM(pb + 8);
        }
        if (INP(pb + 9, 10)) {
            SchedPlain S{(const char*)AX, (const char*)(Wt_co + (size_t)l * DM * CRW), 8, CRW, CRW / 64, F.G, (int)blockIdx.x};
            EpiResid E{X, X};
            pg8::gemm_phase<EpiResid, SchedPlain, PG8_ALIGN, PG8_SP2>(F.lds + RING_OFF, F.wave, CRW, S, E);
            SEAM(pb + 9);
        }
        if (INP(pb + 10, 11)) {
            for (int m = F.gw; m < MT; m += F.ngw) rms_row_to_bf16(X + (size_t)m * DM, norm_mlp_g + (size_t)l * DM, XN + (size_t)m * DM, lane_id());
            SEAM(pb + 10);
        }
        if (INP(pb + 11, 12)) {
            SchedPlain S{(const char*)XN, (const char*)(Wt_1 + (size_t)l * FF * DM), 32, DM, DM / 64, F.G, (int)blockIdx.x};
            EpiRelu2 E{H};
            pg8::gemm_phase<EpiRelu2, SchedPlain, PG8_ALIGN, PG8_SP2>(F.lds + RING_OFF, F.wave, DM, S, E);
            SEAM(pb + 11);
        }
        if (INP(pb + 12, 13)) {
            SchedPlain S{(const char*)H, (const char*)(Wt_2 + (size_t)l * DM * FF), 8, FF, FF / 64, F.G, (int)blockIdx.x};
            EpiResid E{X, X};
            pg8::gemm_phase<EpiResid, SchedPlain, PG8_ALIGN, PG8_SP2>(F.lds + RING_OFF, F.wave, FF, S, E);
            SEAM(pb + 12);
        }
    }
    if (INP(N_PHASES - 1, 14)) {
        for (int m = F.gw; m < MT; m += F.ngw) rms_row_to_f32(X + (size_t)m * DM, final_norm_g, args.out + (size_t)m * DM, lane_id());
    }
#undef IN
#undef SEAM
#undef GRID_BAR
}

extern "C" void kernel_launch(void* const* d_in, const int* in_sizes, int n_in, void* d_out, int out_size, void* d_ws, size_t ws_size, hipStream_t stream) {
    static int grid = 0;
    if (grid == 0) {
        if (n_in != 18 || out_size != MT * DM || ws_size < WS_END) { fprintf(stderr, "kernel_launch: unexpected shapes (n_in %d, out %d, ws %zu < %zu)\n", n_in, out_size, ws_size, (size_t)WS_END); grid = -1; return; }
        int dev = 0, cus = 0, per_cu = 0;
        if (hipGetDevice(&dev) != hipSuccess || hipDeviceGetAttribute(&cus, hipDeviceAttributeMultiprocessorCount, dev) != hipSuccess) { grid = -1; return; }
        if (hipFuncSetAttribute((const void*)enc_fwd, hipFuncAttributeMaxDynamicSharedMemorySize, LDS_BYTES) != hipSuccess) { fprintf(stderr, "kernel_launch: hipFuncSetAttribute failed\n"); grid = -1; return; }
        if (hipOccupancyMaxActiveBlocksPerMultiprocessor(&per_cu, (const void*)enc_fwd, NWAVES * 64, LDS_BYTES) != hipSuccess || per_cu < 1)
            fprintf(stderr, "kernel_launch: occupancy query reports %d workgroups per CU\n", per_cu);
        (void)hipGetLastError();
        grid = cus;
    }
    if (grid < 0) return;
    if (hipMemsetAsync((char*)d_ws + WS_CTL, 0, CTL_ZERO_BYTES, stream) != hipSuccess) return;
    Args a{};
    for (int i = 0; i < 18; ++i) a.in[i] = (const float*)d_in[i];
    a.out = (float*)d_out; a.ws = (unsigned char*)d_ws;
#if MK_LAUNCH_PER_PHASE
    for (int p = 0; p < N_PHASES; ++p) { a.ph_lo = p; a.ph_hi = p + 1; hipLaunchKernelGGL(enc_fwd, dim3(grid), dim3(NWAVES * 64), LDS_BYTES, stream, a); }
#else
    a.ph_lo = 0; a.ph_hi = N_PHASES;
    hipLaunchKernelGGL(enc_fwd, dim3(grid), dim3(NWAVES * 64), LDS_BYTES, stream, a);
#endif
    const hipError_t le = hipPeekAtLastError();
    if (le != hipSuccess) fprintf(stderr, "kernel_launch: launch failed: %s\n", hipGetErrorName(le));
}
```

```cpp
#include <hip/hip_runtime.h>
#include <cstdio>
#include <cstdint>

#ifndef PROBE_A
#define PROBE_A 0
#endif
#ifndef PROBE_B
#define PROBE_B 0
#endif
#define PROBE ((PROBE_A) | (PROBE_B))
#ifndef PROBE_DITHER
#define PROBE_DITHER 0.0f
#endif
#ifndef RESID_LO
#define RESID_LO 0
#endif
#ifndef MK_LAUNCH_PER_PHASE
#define MK_LAUNCH_PER_PHASE 0
#endif

namespace pg8 {
#define PG8_LAS __attribute__((address_space(3)))
typedef unsigned short bf16_t;
typedef short bf16x8 __attribute__((ext_vector_type(8)));
typedef float f32x4 __attribute__((ext_vector_type(4)));
typedef unsigned u32x4 __attribute__((ext_vector_type(4)));
constexpr int BM = 256, BK = 64, HALF = 128, HTB = HALF * BK * 2  , STAGE_BYTES = 8 * HTB, NXCD = 8, WGM = 8;

__host__ __device__ __forceinline__ int lds_byte(int r, int c) { const int st = (r >> 4) * 2 + (c >> 5), rr = r & 15, cc = c & 31, ob = rr * 64 + cc * 2; return st * 1024 + (ob ^ (((ob >> 9) & 1) << 5)); }
__host__ __device__ __forceinline__ void stage_rc(int b, int& R, int& C) { const int st = b / 1024, sb = b % 1024, swz = sb ^ (((sb >> 9) & 1) << 5); R = (st >> 1) * 16 + swz / 64; C = (st & 1) * 32 + (swz % 64) / 2; }
__host__ __device__ __forceinline__ int perm32(int rho) { const int n = rho >> 4, i = rho & 15; return 8 * (i >> 2) + 4 * n + (i & 3); }

struct Unit { int pm, pn, kind; };

__device__ __forceinline__ bool static_tile(int nM, int nN, int G, int c, int i, int& pm, int& pn) {
    const int nwg = nM * nN; const long L = (long)i * G + c; if (L >= nwg) return false;
    int wgid = (int)L; { const int q = nwg / NXCD, r = nwg % NXCD, xcd = wgid % NXCD, off = wgid / NXCD; wgid = (xcd < r ? xcd * (q + 1) : r * (q + 1) + (xcd - r) * q) + off; }
    const int nig = WGM * nN, gid = wgid / nig, fm = gid * WGM, gsz = (nM - fm) < WGM ? (nM - fm) : WGM;
    pm = fm + ((wgid % nig) % gsz); pn = (wgid % nig) / gsz; return true;
}

typedef float f32x2_t __attribute__((ext_vector_type(2))); typedef __bf16 bf16x2_t __attribute__((ext_vector_type(2)));
__device__ __forceinline__ unsigned cvt_pk_bf16(float lo, float hi) { f32x2_t v = {lo, hi}; bf16x2_t b = __builtin_convertvector(v, bf16x2_t); return __builtin_bit_cast(unsigned, b); }

template <class Epi, class Sched, bool ALIGN_EPI = false, bool SP2 = false>
__device__ __forceinline__ void gemm_phase(PG8_LAS unsigned char* lds, const int wave_id, const int ld, const Sched& S, const Epi& E) {
    int lane = (int)__builtin_amdgcn_mbcnt_hi(~0u, __builtin_amdgcn_mbcnt_lo(~0u, 0u)); asm volatile("" : "+v"(lane));
    const int wid = wave_id, tid = wid * 64 + lane, wr = wid >> 2, wc = wid & 3, fr = lane & 15, fq = lane >> 4;
    unsigned voffA[2], voffB[2];
#pragma unroll
    for (int i = 0; i < 2; ++i) { int R, C; stage_rc(tid * 16 + i * 8192, R, C); const int Rb = Epi::PERM ? ((R & ~31) + perm32(R & 31)) : R;
        voffA[i] = (unsigned)(R * ld + C) * 2u; voffB[i] = (unsigned)(Rb * ld + C) * 2u; }
    const size_t kstep = (size_t)(BK * 2);
    const size_t hstep = (size_t)HALF * ld * 2;
    const unsigned ldsw = (unsigned)wid * 1024u;
    const int aoff = lds_byte(wr * 64 + fr, fq * 8), boff = lds_byte(wc * 32 + fr, fq * 8);
#define PG8_SA(b, h) (((b) * 2 + (h)) * HTB)
#define PG8_SB(b, h) ((4 + (b) * 2 + (h)) * HTB)
#define PG8_STAGE(bufoff, gbase, voff) do { _Pragma("unroll") for (int _i = 0; _i < 2; ++_i) \
        __builtin_amdgcn_global_load_lds((const unsigned*)((const char*)(gbase) + (voff)[_i]), (PG8_LAS unsigned*)(lds + (bufoff) + ldsw + _i * 8192), 16, 0, 0); } while (0)
#define PG8_LDA(dst, b, h) do { _Pragma("unroll") for (int m = 0; m < 4; ++m) _Pragma("unroll") for (int k = 0; k < 2; ++k) dst[m][k] = *(const PG8_LAS bf16x8*)(lds + PG8_SA(b, h) + aoff + m * 2048 + k * 1024); } while (0)
#define PG8_LDB(dst, b, h) do { _Pragma("unroll") for (int n = 0; n < 2; ++n) _Pragma("unroll") for (int k = 0; k < 2; ++k) dst[n][k] = *(const PG8_LAS bf16x8*)(lds + PG8_SB(b, h) + boff + n * 2048 + k * 1024); } while (0)
#define PG8_MMA(ai, bj, At, Bt) do { __builtin_amdgcn_s_setprio(1); _Pragma("unroll") for (int m = 0; m < 4; ++m) _Pragma("unroll") for (int n = 0; n < 2; ++n) _Pragma("unroll") for (int k = 0; k < 2; ++k) \
        acc[ai][bj][m][n] = __builtin_amdgcn_mfma_f32_16x16x32_bf16(Bt[n][k], At[m][k], acc[ai][bj][m][n], 0, 0, 0); __builtin_amdgcn_s_setprio(0); } while (0)
#define PG8_WAIT_V(n) asm volatile("s_waitcnt vmcnt(" #n ")" ::: "memory")
#define PG8_WAIT_L(n) asm volatile("s_waitcnt lgkmcnt(" #n ")" ::: "memory")
#define PG8_BAR __builtin_amdgcn_s_barrier()
#define PG8_SCHED __builtin_amdgcn_sched_barrier(0)
    Unit cur, nxt; int ui = 0;
    if (!S.next(0, cur)) return;
    f32x4 acc[2][2][4][2];
#pragma unroll
    for (int a = 0; a < 2; ++a)
#pragma unroll
        for (int b = 0; b < 2; ++b)
#pragma unroll
            for (int m = 0; m < 4; ++m)
#pragma unroll
                for (int n = 0; n < 2; ++n) acc[a][b][m][n] = (f32x4){0.f, 0.f, 0.f, 0.f};
    bf16x8 At[4][2], B0[2][2], B1[2][2];
    const char* cA; const char* cB; int nt;
    S.ptrs(cur, cA, cB, nt);
    if constexpr (SP2) {
        PG8_STAGE(PG8_SB(0, 0), cB, voffB); PG8_STAGE(PG8_SB(0, 1), cB + hstep, voffB); PG8_STAGE(PG8_SA(0, 0), cA, voffA); PG8_STAGE(PG8_SA(0, 1), cA + hstep, voffA);
        if (wr == 1) PG8_BAR;
        PG8_WAIT_V(2); PG8_BAR;
        PG8_STAGE(PG8_SB(1, 0), cB + kstep, voffB); PG8_STAGE(PG8_SA(1, 0), cA + kstep, voffA); PG8_STAGE(PG8_SB(1, 1), cB + hstep + kstep, voffB);
        PG8_WAIT_V(6); PG8_BAR;
    } else {
        PG8_STAGE(PG8_SB(0, 0), cB, voffB); PG8_STAGE(PG8_SA(0, 0), cA, voffA); PG8_STAGE(PG8_SB(0, 1), cB + hstep, voffB); PG8_STAGE(PG8_SA(0, 1), cA + hstep, voffA);
        if (wr == 1) PG8_BAR;
        PG8_WAIT_V(4); PG8_BAR;
        PG8_STAGE(PG8_SB(1, 0), cB + kstep, voffB); PG8_STAGE(PG8_SA(1, 0), cA + kstep, voffA); PG8_STAGE(PG8_SB(1, 1), cB + hstep + kstep, voffB);
        PG8_WAIT_V(6); PG8_BAR;
    }
    for (;;) {
        const bool has_next = S.next(ui + 1, nxt);
        const char* nA = cA; const char* nB = cB; int nnt = nt;
        if (has_next) S.ptrs(nxt, nA, nB, nnt);
        for (int t = 0; t < nt; t += 2) {
            const bool last = (t == nt - 2);
            const char* a1 = cA + (size_t)(t + 1) * kstep;
            const char* a2 = last ? nA : cA + (size_t)(t + 2) * kstep; const char* b2 = last ? nB : cB + (size_t)(t + 2) * kstep;
            const char* a3 = a2 + kstep; const char* b3 = b2 + kstep;
            if constexpr (SP2) {
            PG8_LDB(B0, 0, 0); PG8_LDB(B1, 0, 1); PG8_SCHED; PG8_LDA(At, 0, 0); PG8_STAGE(PG8_SA(1, 1), a1 + hstep, voffA);
            PG8_WAIT_V(8); PG8_WAIT_L(0); PG8_BAR; PG8_MMA(0, 0, At, B0); PG8_MMA(0, 1, At, B1); PG8_BAR; PG8_SCHED;
            PG8_LDA(At, 0, 1); PG8_STAGE(PG8_SB(0, 0), b2, voffB); PG8_STAGE(PG8_SB(0, 1), b2 + hstep, voffB); PG8_STAGE(PG8_SA(0, 0), a2, voffA);
            PG8_WAIT_V(8); PG8_WAIT_L(0); PG8_BAR; PG8_MMA(1, 0, At, B0); PG8_MMA(1, 1, At, B1); PG8_BAR; PG8_SCHED;
            PG8_LDB(B0, 1, 0); PG8_LDB(B1, 1, 1); PG8_SCHED; PG8_LDA(At, 1, 0); PG8_STAGE(PG8_SA(0, 1), a2 + hstep, voffA);
            PG8_WAIT_V(8); PG8_WAIT_L(0); PG8_BAR; PG8_MMA(0, 0, At, B0); PG8_MMA(0, 1, At, B1); PG8_BAR; PG8_SCHED;
            PG8_LDA(At, 1, 1); PG8_STAGE(PG8_SB(1, 0), b3, voffB); PG8_STAGE(PG8_SB(1, 1), b3 + hstep, voffB); PG8_STAGE(PG8_SA(1, 0), a3, voffA);
            PG8_WAIT_V(8); PG8_WAIT_L(0); PG8_BAR; PG8_MMA(1, 0, At, B0); PG8_MMA(1, 1, At, B1); PG8_BAR; PG8_SCHED;
            } else {
            PG8_LDB(B0, 0, 0); PG8_SCHED; PG8_LDA(At, 0, 0); PG8_STAGE(PG8_SA(1, 1), a1 + hstep, voffA);
            PG8_WAIT_L(8); PG8_BAR; PG8_WAIT_L(0); PG8_MMA(0, 0, At, B0); PG8_BAR; PG8_SCHED;
            PG8_LDB(B1, 0, 1); PG8_STAGE(PG8_SB(0, 0), b2, voffB);
            PG8_BAR; PG8_WAIT_L(0); PG8_MMA(0, 1, At, B1); PG8_BAR;
            PG8_LDA(At, 0, 1); PG8_STAGE(PG8_SA(0, 0), a2, voffA);
            PG8_BAR; PG8_WAIT_L(0); PG8_MMA(1, 0, At, B0); PG8_BAR; PG8_SCHED;
            PG8_STAGE(PG8_SB(0, 1), b2 + hstep, voffB);
            PG8_WAIT_V(6); PG8_BAR; PG8_MMA(1, 1, At, B1); PG8_BAR;
            PG8_LDB(B0, 1, 0); PG8_SCHED; PG8_LDA(At, 1, 0); PG8_STAGE(PG8_SA(0, 1), a2 + hstep, voffA);
            PG8_WAIT_L(8); PG8_BAR; PG8_WAIT_L(0); PG8_MMA(0, 0, At, B0); PG8_BAR; PG8_SCHED;
            PG8_LDB(B1, 1, 1); PG8_STAGE(PG8_SB(1, 0), b3, voffB);
            PG8_BAR; PG8_WAIT_L(0); PG8_MMA(0, 1, At, B1); PG8_BAR;
            PG8_LDA(At, 1, 1); PG8_STAGE(PG8_SA(1, 0), a3, voffA);
            PG8_BAR; PG8_WAIT_L(0); PG8_MMA(1, 0, At, B0); PG8_BAR; PG8_SCHED;
            PG8_STAGE(PG8_SB(1, 1), b3 + hstep, voffB);
            PG8_WAIT_V(6); PG8_BAR; PG8_MMA(1, 1, At, B1); PG8_BAR;
            }
        }
        if constexpr (ALIGN_EPI) { if (wr == 0) PG8_BAR; }
        E(acc, cur, wr, wc, fr, fq);
        if (!has_next) break;
#pragma unroll
        for (int a = 0; a < 2; ++a)
#pragma unroll
            for (int b = 0; b < 2; ++b)
#pragma unroll
                for (int m = 0; m < 4; ++m)
#pragma unroll
                    for (int n = 0; n < 2; ++n) acc[a][b][m][n] = (f32x4){0.f, 0.f, 0.f, 0.f};
        cur = nxt; cA = nA; cB = nB; nt = nnt; ++ui;
        if constexpr (ALIGN_EPI) { if (wr == 1) PG8_BAR; }
    }
    PG8_WAIT_V(0);
    if constexpr (!ALIGN_EPI) { if (wr == 0) PG8_BAR; }
    PG8_BAR;
#undef PG8_SA
#undef PG8_SB
#undef PG8_STAGE
#undef PG8_LDA
#undef PG8_LDB
#undef PG8_MMA
#undef PG8_WAIT_V
#undef PG8_WAIT_L
#undef PG8_BAR
#undef PG8_SCHED
}
}

#ifndef P2_SKEW
#define P2_SKEW 0
#endif
#ifndef PG8_SP2
#define PG8_SP2 true
#endif
#ifndef PG8_ALIGN
#define PG8_ALIGN true
#endif

constexpr int NWAVES = 8;
constexpr int DM = 2048, NB = 2, SEQ = 4096, MT = NB * SEQ, DEPTH = 4, MEML = 256, MEMT = NB * MEML;
constexpr int INW = 13824, MIXW = 2560, FF = 8192, CRW = 512;
constexpr int U_QA = 0, U_KA = 768, U_VA = 1536, U_QB = 2304, U_KB = 2816, U_VB = 3328, U_GR = 4352, U_QC = 5376, U_KC = 6144, U_VC = 6912, U_SA = 7680;
constexpr float EPSF = 1e-6f, LOG2E = 1.4426950408889634f;
constexpr float QSCALE = 0.08838834764831845f;

constexpr size_t MiB = 1u << 20;
constexpr size_t WS_CTL = 0, CTL_ZERO_BYTES = 128 * 1024;
constexpr size_t WS_ROPE = 2 * MiB;
constexpr size_t WS_WIN = 8 * MiB;
constexpr size_t SZ_WIN = (size_t)DEPTH * INW * DM * 2;
constexpr size_t WS_WBR = WS_WIN + SZ_WIN;
constexpr size_t SZ_WBR = (size_t)DEPTH * DM * MIXW * 2;
constexpr size_t WS_WOUT = WS_WBR + SZ_WBR;
constexpr size_t SZ_WOUT = (size_t)DEPTH * DM * DM * 2;
constexpr size_t WS_WCQ = WS_WOUT + SZ_WOUT;
constexpr size_t SZ_WCQ = (size_t)DEPTH * CRW * DM * 2;
constexpr size_t WS_WCKV = WS_WCQ + SZ_WCQ;
constexpr size_t SZ_WCKV = (size_t)DEPTH * 2 * CRW * DM * 2;
constexpr size_t WS_WCO = WS_WCKV + SZ_WCKV;
constexpr size_t SZ_WCO = (size_t)DEPTH * DM * CRW * 2;
constexpr size_t WS_W1 = WS_WCO + SZ_WCO;
constexpr size_t SZ_W1 = (size_t)DEPTH * FF * DM * 2;
constexpr size_t WS_W2 = WS_W1 + SZ_W1;
constexpr size_t SZ_W2 = (size_t)DEPTH * DM * FF * 2;
constexpr size_t WS_MN = WS_W2 + SZ_W2;
constexpr size_t SZ_MN = (size_t)DEPTH * MEMT * DM * 2;
constexpr size_t WS_X = WS_MN + SZ_MN;
constexpr size_t SZ_X = (size_t)MT * DM * 4;
constexpr size_t WS_XN = WS_X + SZ_X;
constexpr size_t SZ_XN = (size_t)MT * DM * 2;
constexpr size_t WS_U = WS_XN + SZ_XN;
constexpr size_t SZ_U = (size_t)MT * INW * 2;
constexpr size_t WS_H = WS_U;
constexpr size_t WS_VBT = WS_U + SZ_U;
constexpr size_t SZ_VBT = (size_t)1024 * MT * 2;
constexpr size_t WS_KBT = WS_VBT + SZ_VBT;
constexpr size_t SZ_KBT = (size_t)512 * MT * 2;
constexpr size_t WS_ST = WS_KBT + SZ_KBT;
constexpr size_t SZ_ST = (size_t)2 * 2 * 4 * 32 * 256 * 128 * 2;
constexpr size_t WS_OMIX = WS_ST + SZ_ST;
constexpr size_t SZ_OMIX = (size_t)MT * MIXW * 2;
constexpr size_t WS_PO = WS_OMIX + SZ_OMIX;
constexpr size_t SZ_PO = (size_t)3 * MT * 768 * 4;
constexpr size_t WS_PL = WS_PO + SZ_PO;
constexpr size_t SZ_PL = (size_t)3 * MT * 8 * 4;
constexpr size_t WS_MPART = WS_PL + SZ_PL;
constexpr size_t SZ_MPART = (size_t)MT * DM * 4;
constexpr size_t WS_MERGED = WS_MPART + SZ_MPART;
constexpr size_t SZ_MERGED = (size_t)MT * DM * 2;
constexpr size_t WS_QX = WS_MERGED + SZ_MERGED;
constexpr size_t SZ_QX = (size_t)MT * CRW * 2;
constexpr size_t WS_KX = WS_QX + SZ_QX;
constexpr size_t SZ_KX = (size_t)DEPTH * MEMT * 2 * CRW * 2;
constexpr size_t WS_VXT = WS_KX + SZ_KX;
constexpr size_t SZ_VXT = (size_t)CRW * MEMT * 2;
constexpr size_t WS_AX = WS_VXT + SZ_VXT;
constexpr size_t SZ_AX = (size_t)MT * CRW * 2;
constexpr size_t WS_RS = WS_AX + SZ_AX;
constexpr size_t SZ_RS = (size_t)13 * MT * 32 * 4;
constexpr size_t WS_END = WS_RS + SZ_RS;
static_assert((size_t)MT * FF * 2 <= SZ_U, "h overlays u");

constexpr int CW_TMO = 0, CW_CODE = 1;
constexpr int CW_BAR = 4096, CW_CLAIM = 2048;

constexpr int RING_OFF = 0, RING_BYTES = 131072;
constexpr int LDSCTL_OFF = RING_BYTES, MISC_OFF = LDSCTL_OFF + 320;
constexpr int LDS_BYTES = 147456;
constexpr int LDS_RPB = 98304, LDS_T5 = 98304 + 12288;
static_assert(MISC_OFF + 128 <= LDS_BYTES, "LDS map");

#define GAS __attribute__((address_space(1)))
#define LAS __attribute__((address_space(3)))
typedef unsigned short bf16;
typedef unsigned v4u __attribute__((ext_vector_type(4)));
typedef unsigned v2u __attribute__((ext_vector_type(2)));
typedef float f32x4 __attribute__((ext_vector_type(4)));
typedef float f32x2 __attribute__((ext_vector_type(2)));
typedef short bf16x8 __attribute__((ext_vector_type(8)));
typedef short s16x4 __attribute__((ext_vector_type(4)));
typedef GAS unsigned gu32;
#define RLX_AGENT __ATOMIC_RELAXED, __HIP_MEMORY_SCOPE_AGENT
#define LDS_WAIT() asm volatile("s_waitcnt lgkmcnt(0)" ::: "memory")
#define VM_WAIT() asm volatile("s_waitcnt vmcnt(0)" ::: "memory")
__device__ __forceinline__ unsigned f2bf(float f) { unsigned u = __builtin_bit_cast(unsigned, f); return (u + 0x7fffu + ((u >> 16) & 1u)) >> 16; }
__device__ __forceinline__ unsigned pk2(float lo, float hi) { return pg8::cvt_pk_bf16(lo, hi); }
__device__ __forceinline__ float bf2f(unsigned short b) { return __builtin_bit_cast(float, (unsigned)b << 16); }
__device__ __forceinline__ float bflo(unsigned w) { return __builtin_bit_cast(float, w << 16); }
__device__ __forceinline__ float bfhi(unsigned w) { return __builtin_bit_cast(float, w & 0xffff0000u); }
#define MFMA16(a, b, c) __builtin_amdgcn_mfma_f32_16x16x32_bf16((a), (b), (c), 0, 0, 0)
__device__ __forceinline__ bf16x8 ldg8(const bf16* p) { return *(const GAS bf16x8*)p; }
typedef __amdgpu_buffer_rsrc_t rsrc_t;
__device__ __forceinline__ rsrc_t mk_rsrc(const void* base, size_t bytes) { return __builtin_amdgcn_make_buffer_rsrc((void*)base, (short)0, (int)(unsigned)bytes, 0x00020000); }
__device__ __forceinline__ bf16x8 ldb8(rsrc_t r, unsigned voff, unsigned soff) { return __builtin_bit_cast(bf16x8, __builtin_amdgcn_raw_buffer_load_b128(r, (int)voff, (int)soff, 0)); }
__device__ __forceinline__ bf16x8 ldg8s(const bf16* ubase, unsigned voff_bytes) { return *(const GAS bf16x8*)((const GAS char*)ubase + voff_bytes); }
__device__ __forceinline__ unsigned cvtpk(float lo, float hi) { return pg8::cvt_pk_bf16(lo, hi); }
__device__ __forceinline__ bf16x8 pack8(const float* v) { v4u w; w.x = cvtpk(v[0], v[1]); w.y = cvtpk(v[2], v[3]); w.z = cvtpk(v[4], v[5]); w.w = cvtpk(v[6], v[7]); return __builtin_bit_cast(bf16x8, w); }

#define XB_TMO      128
#define XB_XCNT(j)  (256  + 64 * (j))
#define XB_XSUB(j)  (1280 + 64 * (j))
#define XB_XGEN(j)  (2304 + 64 * (j))
#define XB_TOP      3328
#define XB_TOPGEN   3392
#define XCD_BAR_WORDS 3456
#define XB_SPIN_CAP (1u << 18)

__device__ __forceinline__ unsigned xb_ld(unsigned* p)              { return __hip_atomic_load(p, __ATOMIC_RELAXED, __HIP_MEMORY_SCOPE_AGENT); }
__device__ __forceinline__ unsigned xb_add(unsigned* p, unsigned v) { return __hip_atomic_fetch_add(p, v, __ATOMIC_RELAXED, __HIP_MEMORY_SCOPE_AGENT); }
__device__ __forceinline__ unsigned xb_xcc_id() { return (unsigned)__builtin_amdgcn_s_getreg((3 << 11) | 20) & 0xFu; }
#define XB_SPIN(cond, bar) do { unsigned _sp = 0; while (cond) { __builtin_amdgcn_s_sleep(1); \
    if ((++_sp & 255u) == 0u) { if (xb_ld(&(bar)[XB_TMO])) break; if (_sp > XB_SPIN_CAP) { atomicAdd(&(bar)[XB_TMO], 1u); break; } } } } while (0)

struct XcdBarrier {
    unsigned* bar; unsigned x;
    volatile LAS unsigned* st;
};
__device__ __forceinline__ XcdBarrier xcd_barrier_post(unsigned* bar, volatile LAS unsigned* st, const bool t0) {
    XcdBarrier b; b.bar = bar; b.x = xb_xcc_id(); b.st = st;
    if (t0) (void)xb_add(&bar[XB_XCNT(b.x)], 1u);
    return b;
}
__device__ __forceinline__ void xcd_barrier_complete(unsigned* bar, unsigned x, unsigned& nloc, unsigned& nx) {
    const unsigned G = gridDim.x * gridDim.y * gridDim.z;
    unsigned sum, cnt, mine, sp = 0u;
    for (;;) {
        sum = 0u; cnt = 0u; mine = 0u;
#pragma unroll
        for (unsigned j = 0; j < 16; ++j) { const unsigned c = xb_ld(&bar[XB_XCNT(j)]); sum += c; cnt += (c > 0u) ? 1u : 0u; mine = (j == x) ? c : mine; }
        if (sum == G) break;
        __builtin_amdgcn_s_sleep(1);
        if ((++sp & 255u) == 0u) { if (xb_ld(&bar[XB_TMO])) break; if (sp > XB_SPIN_CAP) { atomicAdd(&bar[XB_TMO], 1u); break; } }
    }
    nloc = mine > 0u ? mine : 1u; nx = cnt > 0u ? cnt : 1u;
}
__device__ __forceinline__ void xcd_barrier(const XcdBarrier& b, const bool t0) {
    asm volatile("s_waitcnt vmcnt(0)" ::: "memory");
    __syncthreads();
    if (t0) {
        unsigned* bar = b.bar;
        __builtin_amdgcn_s_waitcnt(0);
        unsigned nloc = b.st[0], nx = b.st[1];
        if (nloc == 0u) { xcd_barrier_complete(bar, b.x, nloc, nx); b.st[0] = nloc; b.st[1] = nx; }
        const unsigned old = xb_add(&bar[XB_XSUB(b.x)], 1u);
        const unsigned gen = old / nloc;
        if (old + 1u == (gen + 1u) * nloc) {
            __builtin_amdgcn_fence(__ATOMIC_RELEASE, "agent");
            asm volatile("s_waitcnt vmcnt(0)" ::: "memory");
            const unsigned og = xb_add(&bar[XB_TOP], 1u);
            const unsigned tg = og / nx;
            if (og + 1u == (tg + 1u) * nx) xb_add(&bar[XB_TOPGEN], 1u);
            else XB_SPIN(xb_ld(&bar[XB_TOPGEN]) == tg, bar);
            __builtin_amdgcn_fence(__ATOMIC_ACQUIRE, "agent");
            xb_add(&bar[XB_XGEN(b.x)], 1u);
            asm volatile("s_waitcnt vmcnt(0)" ::: "memory");
        } else {
            XB_SPIN(xb_ld(&bar[XB_XGEN(b.x)]) == gen, bar);
            __builtin_amdgcn_fence(__ATOMIC_ACQUIRE, "agent");
            asm volatile("s_waitcnt vmcnt(0)" ::: "memory");
        }
    }
    __syncthreads();
}

struct Frame {
    LAS unsigned char* lds;
    int wave;
    int vcu, G;
    int gw, ngw;
};

__device__ __forceinline__ int opq(int x) { asm volatile("" : "+s"(x)); return x; }
__device__ __forceinline__ int lane_id() { int l = (int)__builtin_amdgcn_mbcnt_hi(~0u, __builtin_amdgcn_mbcnt_lo(~0u, 0u)); asm volatile("" : "+v"(l)); return l; }
__device__ __forceinline__ float shx(float v, int mask, int lane) { return __builtin_bit_cast(float, __builtin_amdgcn_ds_bpermute((lane ^ mask) << 2, __builtin_bit_cast(int, v))); }
__device__ __forceinline__ float wave_sum(float v, int lane) {
#pragma unroll
    for (int o = 1; o < 64; o <<= 1) v += shx(v, o, lane);
    return v;
}

__device__ __forceinline__ float rope_inv_freq(int i) {
    constexpr float t[64] = {0x1.000000p+0f, 0x1.bb5faep-1f, 0x1.7ff224p-1f, 0x1.4c7bc0p-1f, 0x1.1feb34p-1f, 0x1.f2a79ep-2f, 0x1.afd136p-2f, 0x1.75f034p-2f, 0x1.43d136p-2f, 0x1.186a08p-2f, 0x1.e5a848p-3f, 0x1.a48fdap-3f, 0x1.6c310ep-3f, 0x1.3b6080p-3f, 0x1.111aecp-3f, 0x1.d8ffacp-4f,
        0x1.99999ap-4f, 0x1.62b2f0p-4f, 0x1.33281ap-4f, 0x1.09fc9ap-4f, 0x1.ccab86p-5f, 0x1.8eec7ep-5f, 0x1.59742cp-5f, 0x1.2b2690p-5f, 0x1.030dc4p-5f, 0x1.c0a9a6p-6f, 0x1.8486a0p-6f, 0x1.507316p-6f, 0x1.235a72p-6f, 0x1.f89a66p-7f, 0x1.b4f7e4p-7f, 0x1.7a6624p-7f,
        0x1.47ae14p-7f, 0x1.1bc25ap-7f, 0x1.eb735ep-8f, 0x1.a99428p-8f, 0x1.708938p-8f, 0x1.3f2398p-8f, 0x1.145ceep-8f, 0x1.dea41ap-9f, 0x1.9e7c6ep-9f, 0x1.66ee1ep-9f, 0x1.36d218p-9f, 0x1.0d28dcp-9f, 0x1.d22a50p-10f, 0x1.93aeb8p-10f, 0x1.5d931cp-10f, 0x1.2eb81ap-10f,
        0x1.0624dep-10f, 0x1.c603c4p-11f, 0x1.89291ap-11f, 0x1.547688p-11f, 0x1.26d42cp-11f, 0x1.fe9f5ap-12f, 0x1.ba2e4cp-12f, 0x1.7ee9b0p-12f, 0x1.4b96bep-12f, 0x1.1f24e4p-12f, 0x1.f15028p-13f, 0x1.aea7cap-13f, 0x1.74eea6p-13f, 0x1.42f22cp-13f, 0x1.17a8e4p-13f, 0x1.e459c6p-14f};
    float r = 0.f;
#pragma unroll
    for (int k = 0; k < 64; ++k) r = (i == k) ? t[k] : r;
    return r;
}
__device__ __forceinline__ void sincos_f32(float angf, float& s, float& c) {
    const double x = (double)angf;
    const double k = __builtin_rint(x * 0.63661977236758134308);
    const double y = (x - k * 1.5707963267948966192) - k * 6.123233995736766e-17;
    const double y2 = y * y;
    double sp = 1.0 / 1307674368000.0;
    sp = -sp * y2 + 1.0 / 6227020800.0; sp = -sp * y2 + 1.0 / 39916800.0; sp = -sp * y2 + 1.0 / 362880.0; sp = -sp * y2 + 1.0 / 5040.0; sp = -sp * y2 + 1.0 / 120.0; sp = -sp * y2 + 1.0 / 6.0; sp = -sp * y2 + 1.0;
    const double sy = sp * y;
    double cp = 1.0 / 87178291200.0;
    cp = -cp * y2 + 1.0 / 479001600.0; cp = -cp * y2 + 1.0 / 3628800.0; cp = -cp * y2 + 1.0 / 40320.0; cp = -cp * y2 + 1.0 / 720.0; cp = -cp * y2 + 1.0 / 24.0; cp = -cp * y2 + 0.5; cp = -cp * y2 + 1.0;
    const int q = ((int)k) & 3;
    const double ss = (q == 0) ? sy : (q == 1) ? cp : (q == 2) ? -sy : -cp;
    const double cc = (q == 0) ? cp : (q == 1) ? -sy : (q == 2) ? -cp : sy;
    s = (float)ss; c = (float)cc;
}

template <int MAP>
__device__ __forceinline__ void p0_transpose_item(const float* W, int K, int N, bf16* WT, LAS float* scr, int item, int lane, const float* gk = nullptr) {
    const int nblk = N / 32, kb = item / nblk, nb = item % nblk, k0 = 64 * kb, n0 = 32 * nb;
    const int c4 = lane & 7, r = lane >> 3;
    int src = n0 + 4 * c4, dst = 4 * c4, dstep = 1; float sc = 1.f;
    if (MAP == 1) {
        if (n0 >= U_QB && n0 < U_VB) { const int hbase = n0 & ~127, p0 = n0 & 127; src = hbase + (p0 >> 1) + 4 * (c4 & 3) + 64 * (c4 >> 2); dst = 8 * (c4 & 3) + (c4 >> 2); dstep = 2; if (n0 >= U_KB) sc = QSCALE; }
        else if (n0 < U_KA || (n0 >= U_QC && n0 < U_KC)) sc = QSCALE * LOG2E;
    }
    if (MAP == 2) sc = QSCALE * LOG2E;
    f32x4 v[8];
#pragma unroll
    for (int i = 0; i < 8; ++i) v[i] = *(const GAS f32x4*)(W + (size_t)(k0 + 8 * i + r) * N + src);
#pragma unroll
    for (int i = 0; i < 8; ++i) { if (gk) v[i] = v[i] * ((const GAS float*)gk)[k0 + 8 * i + r];
        LAS float* d = scr + (8 * i + r) * 33 + dst; d[0] = v[i][0] * sc; d[dstep] = v[i][1] * sc; d[2 * dstep] = v[i][2] * sc; d[3 * dstep] = v[i][3] * sc; }
    LDS_WAIT(); asm volatile("" ::: "memory");
    const int c = lane & 7;
#pragma unroll
    for (int j = 0; j < 4; ++j) { const int n = (lane >> 3) + 8 * j; const LAS float* s = scr + (8 * c) * 33 + n;
        v4u o; o.x = pk2(s[0 * 33], s[1 * 33]); o.y = pk2(s[2 * 33], s[3 * 33]); o.z = pk2(s[4 * 33], s[5 * 33]); o.w = pk2(s[6 * 33], s[7 * 33]);
        *(GAS v4u*)(WT + (size_t)(n0 + n) * K + k0 + 8 * c) = o; }
    LDS_WAIT(); asm volatile("" ::: "memory");
}

struct P0Desc { const float* W; bf16* WT; const float* gk; int K, N, map, item; };
__device__ __forceinline__ void p0_issue(const P0Desc& d, int lane, f32x4 (&v)[8], float (&gv)[8]) {
    const int nblk = d.N / 32, kb = d.item / nblk, nb = d.item % nblk, k0 = 64 * kb, n0 = 32 * nb;
    const int c4 = lane & 7, r = lane >> 3;
    int src = n0 + 4 * c4;
    if (d.map == 1 && n0 >= U_QB && n0 < U_VB) { const int hbase = n0 & ~127, p0 = n0 & 127; src = hbase + (p0 >> 1) + 4 * (c4 & 3) + 64 * (c4 >> 2); }
#pragma unroll
    for (int i = 0; i < 8; ++i) v[i] = *(const GAS f32x4*)(d.W + (size_t)(k0 + 8 * i + r) * d.N + src);
    if (d.gk) {
#pragma unroll
        for (int i = 0; i < 8; ++i) gv[i] = ((const GAS float*)d.gk)[k0 + 8 * i + r];
    } else {
#pragma unroll
        for (int i = 0; i < 8; ++i) gv[i] = 1.f;
    }
}
__device__ __forceinline__ void p0_finish(const P0Desc& d, int lane, LAS float* scr, const f32x4 (&v)[8], const float (&gv)[8]) {
    const int nblk = d.N / 32, kb = d.item / nblk, nb = d.item % nblk, k0 = 64 * kb, n0 = 32 * nb;
    const int c4 = lane & 7, r = lane >> 3;
    int dst = 4 * c4, dstep = 1; float sc = 1.f;
    if (d.map == 1) {
        if (n0 >= U_QB && n0 < U_VB) { dst = 8 * (c4 & 3) + (c4 >> 2); dstep = 2; if (n0 >= U_KB) sc = QSCALE; }
        else if (n0 < U_KA || (n0 >= U_QC && n0 < U_KC)) sc = QSCALE * LOG2E;
    }
    if (d.map == 2) sc = QSCALE * LOG2E;
#pragma unroll
    for (int i = 0; i < 8; ++i) { const float f = sc * gv[i];
        LAS float* q = scr + (8 * i + r) * 33 + dst; q[0] = v[i][0] * f; q[dstep] = v[i][1] * f; q[2 * dstep] = v[i][2] * f; q[3 * dstep] = v[i][3] * f; }
    LDS_WAIT(); asm volatile("" ::: "memory");
    const int c = lane & 7;
#pragma unroll
    for (int j = 0; j < 4; ++j) { const int n = (lane >> 3) + 8 * j; const LAS float* s_ = scr + (8 * c) * 33 + n;
        v4u o; o.x = pk2(s_[0 * 33], s_[1 * 33]); o.y = pk2(s_[2 * 33], s_[3 * 33]); o.z = pk2(s_[4 * 33], s_[5 * 33]); o.w = pk2(s_[6 * 33], s_[7 * 33]);
        *(GAS v4u*)(d.WT + (size_t)(n0 + n) * d.K + k0 + 8 * c) = o; }
    LDS_WAIT(); asm volatile("" ::: "memory");
}

__device__ __forceinline__ void rms_row_to_bf16(const float* xrow, const float* g, bf16* orow, int lane) {
    const GAS f32x4* xr = (const GAS f32x4*)xrow + lane; const GAS f32x4* gr = (const GAS f32x4*)g + lane;
    f32x4 v[8]; float s = 0.f;
#pragma unroll
    for (int j = 0; j < 8; ++j) { v[j] = xr[64 * j]; s += (v[j].x * v[j].x + v[j].y * v[j].y) + (v[j].z * v[j].z + v[j].w * v[j].w); }
    const float rs = 1.0f / sqrtf(wave_sum(s, lane) * (1.f / DM) + EPSF);
    GAS v2u* o8 = (GAS v2u*)orow + lane;
#pragma unroll
    for (int j = 0; j < 8; ++j) { const f32x4 gg = gr[64 * j]; v2u w; w.x = pk2(v[j].x * rs * gg.x, v[j].y * rs * gg.y); w.y = pk2(v[j].z * rs * gg.z, v[j].w * rs * gg.w); o8[64 * j] = w; }
}
__device__ __forceinline__ void row_to_bf16_ss(const float* xrow, bf16* orow, float* ssp, int lane) {
    const GAS f32x4* xr = (const GAS f32x4*)xrow + lane;
    f32x4 v[8]; float s = 0.f;
#pragma unroll
    for (int j = 0; j < 8; ++j) { v[j] = xr[64 * j]; s += (v[j].x * v[j].x + v[j].y * v[j].y) + (v[j].z * v[j].z + v[j].w * v[j].w); }
    s = wave_sum(s, lane);
    GAS v2u* o8 = (GAS v2u*)orow + lane;
#pragma unroll
    for (int j = 0; j < 8; ++j) { v2u w; w.x = pk2(v[j].x, v[j].y); w.y = pk2(v[j].z, v[j].w); o8[64 * j] = w; }
    if (lane < 32) ((GAS float*)ssp)[lane] = (lane == 0) ? s : 0.f;
}
__device__ __forceinline__ float rs_of(float ss) { return 1.0f / sqrtf(ss * (1.f / DM) + EPSF); }
__device__ __forceinline__ float rs_row4(const float* part, int row, int fq, int lane) {
    const f32x4 a = *(const GAS f32x4*)(part + (size_t)row * 32 + 8 * fq), b = *(const GAS f32x4*)(part + (size_t)row * 32 + 8 * fq + 4);
    float s = ((a[0] + a[1]) + (a[2] + a[3])) + ((b[0] + b[1]) + (b[2] + b[3]));
    s += shx(s, 16, lane); s += shx(s, 32, lane);
    return rs_of(s);
}
__device__ __forceinline__ void rs_rows_tile(const float* part, int rbase, int fq, int lane, float (&rs)[8]) {
    f32x4 pa[8], pb[8];
#pragma unroll
    for (int i = 0; i < 8; ++i) { const size_t row = (size_t)(rbase + 128 * (i >> 2) + 16 * (i & 3)); pa[i] = *(const GAS f32x4*)(part + row * 32 + 8 * fq); pb[i] = *(const GAS f32x4*)(part + row * 32 + 8 * fq + 4); }
#pragma unroll
    for (int i = 0; i < 8; ++i) { float s_ = ((pa[i][0] + pa[i][1]) + (pa[i][2] + pa[i][3])) + ((pb[i][0] + pb[i][1]) + (pb[i][2] + pb[i][3]));
        s_ += shx(s_, 16, lane); s_ += shx(s_, 32, lane); rs[i] = rs_of(s_); }
}
__device__ __forceinline__ void rs_rows8x16(const float* part, int t0, int fr, int lane, float (&rs)[8]) {
    f32x2 a[8];
#pragma unroll
    for (int e = 0; e < 8; ++e) a[e] = *(const GAS f32x2*)(part + (size_t)(t0 + e) * 32 + 2 * fr);
#pragma unroll
    for (int e = 0; e < 8; ++e) { float s = a[e][0] + a[e][1];
        s += shx(s, 1, lane); s += shx(s, 2, lane); s += shx(s, 4, lane); s += shx(s, 8, lane); rs[e] = rs_of(s); }
}
__device__ __forceinline__ void rms_row_to_f32(const bf16* xhi, const bf16* xlo, const float* g, float* orow, int lane, float oscale, const float* ssp) {
    const GAS v2u* hr = (const GAS v2u*)xhi + lane; const GAS v2u* lr = (const GAS v2u*)xlo + lane; const GAS f32x4* gr = (const GAS f32x4*)g + lane;
    float ssum = (lane < 32) ? ((const GAS float*)ssp)[lane] : 0.f; ssum = wave_sum(ssum, lane);
    const float rs = oscale * rs_of(ssum);
    GAS f32x4* o = (GAS f32x4*)orow + lane;
#pragma unroll
    for (int j = 0; j < 8; ++j) { const v2u h_ = hr[64 * j]; v2u l_ = {0u, 0u}; if (RESID_LO) l_ = lr[64 * j]; const f32x4 gg = gr[64 * j];
        f32x4 x; x[0] = bflo(h_.x) + bflo(l_.x); x[1] = bfhi(h_.x) + bfhi(l_.x); x[2] = bflo(h_.y) + bflo(l_.y); x[3] = bfhi(h_.y) + bfhi(l_.y);
        o[64 * j] = x * rs * gg; }
}

using pg8::Unit;
constexpr size_t TSTEP_DM = (size_t)256 * DM * 2;

struct SchedIn {
    const char* xn; const char* wt; int G, c;
    __device__ __forceinline__ bool next(int i, Unit& u) const {
        int pm, vn; if (!pg8::static_tile(32, 56, G, c, i, pm, vn)) return false;
        u.pm = pm; u.pn = vn; u.kind = (vn >= 54) ? 3 : (vn >= 13 && vn < 17) ? 2 : (vn >= 9 && vn < 13) ? 1 : 0; return true;
    }
    __device__ __forceinline__ void ptrs(const Unit& u, const char*& a, const char*& b, int& nt) const {
        nt = DM / 64;
        if (u.kind >= 2) { const int f = (u.kind == 3) ? 11 + (u.pn - 54) : u.pn; a = wt + (size_t)f * TSTEP_DM; b = xn + (size_t)u.pm * TSTEP_DM; }
        else { a = xn + (size_t)u.pm * TSTEP_DM; b = wt + (size_t)u.pn * TSTEP_DM; }
    }
};
struct EpiIn {
    static constexpr bool PERM = true;
    bf16* u; bf16* vbT; bf16* kbT; const float* rope; const float* rss; mutable int pm_c = -1; mutable float rsv_c[8] = {};
    __device__ __forceinline__ void operator()(const f32x4 (&acc)[2][2][4][2], const Unit& un, int wr, int wc, int fr, int fq) const {
        asm volatile("" : "+v"(fr), "+v"(fq));
        const int r0 = wr * 64 + fr, c0 = wc * 32 + 8 * fq;
        if (un.kind < 2 && pm_c != un.pm) { rs_rows_tile(rss, un.pm * 256 + r0, fq, 16 * fq + fr, rsv_c); pm_c = un.pm; }
        const float (&rsv)[8] = rsv_c;
        if (un.kind == 0) {
#pragma unroll
            for (int ai = 0; ai < 2; ++ai)
#pragma unroll
                for (int m = 0; m < 4; ++m) { bf16* rowp = u + (size_t)(un.pm * 256 + r0 + ai * 128 + m * 16) * INW + un.pn * 256 + c0;
                    const float rs = rsv[ai * 4 + m];
#pragma unroll
                    for (int bj = 0; bj < 2; ++bj) { const f32x4 v0 = acc[ai][bj][m][0] * rs, v1 = acc[ai][bj][m][1] * rs;
                        v4u w; w.x = pg8::cvt_pk_bf16(v0[0], v0[1]); w.y = pg8::cvt_pk_bf16(v0[2], v0[3]); w.z = pg8::cvt_pk_bf16(v1[0], v1[1]); w.w = pg8::cvt_pk_bf16(v1[2], v1[3]);
                        *(GAS v4u*)(rowp + bj * 128) = w; } }
        } else if (un.kind == 1) {
            const int i0 = 16 * wc + 4 * fq;
#pragma unroll
            for (int ai = 0; ai < 2; ++ai)
#pragma unroll
                for (int m = 0; m < 4; ++m) { const int row = un.pm * 256 + r0 + ai * 128 + m * 16, t = row & (SEQ - 1);
                    const f32x4 cs = *(const GAS f32x4*)(rope + (size_t)t * 64 + i0), sn = *(const GAS f32x4*)(rope + (size_t)SEQ * 64 + (size_t)t * 64 + i0);
                    bf16* rowp = u + (size_t)row * INW + un.pn * 256 + c0;
                    const float rs = rsv[ai * 4 + m];
#pragma unroll
                    for (int bj = 0; bj < 2; ++bj) { const f32x4 v0 = acc[ai][bj][m][0] * rs, v1 = acc[ai][bj][m][1] * rs;
                        v4u w; w.x = pg8::cvt_pk_bf16(v0[0] * cs[0] - v0[1] * sn[0], v0[0] * sn[0] + v0[1] * cs[0]);
                        w.y = pg8::cvt_pk_bf16(v0[2] * cs[1] - v0[3] * sn[1], v0[2] * sn[1] + v0[3] * cs[1]);
                        w.z = pg8::cvt_pk_bf16(v1[0] * cs[2] - v1[1] * sn[2], v1[0] * sn[2] + v1[1] * cs[2]);
                        w.w = pg8::cvt_pk_bf16(v1[2] * cs[3] - v1[3] * sn[3], v1[2] * sn[3] + v1[3] * cs[3]);
                        *(GAS v4u*)(rowp + bj * 128) = w; }
                    asm volatile("" ::: "memory"); }
        } else if (un.kind == 2) {
            float rsc[2][8]; rs_rows8x16(rss, un.pm * 256 + c0, fr, 16 * fq + fr, rsc[0]); rs_rows8x16(rss, un.pm * 256 + c0 + 128, fr, 16 * fq + fr, rsc[1]);
#pragma unroll
            for (int ai = 0; ai < 2; ++ai)
#pragma unroll
                for (int m = 0; m < 4; ++m) { bf16* rowp = vbT + (size_t)((un.pn - 13) * 256 + r0 + ai * 128 + m * 16) * MT + un.pm * 256 + c0;
#pragma unroll
                    for (int bj = 0; bj < 2; ++bj) { f32x4 v0 = acc[ai][bj][m][0], v1 = acc[ai][bj][m][1];
#pragma unroll
                        for (int e = 0; e < 4; ++e) { v0[e] *= rsc[bj][e]; v1[e] *= rsc[bj][4 + e]; }
                        v4u w; w.x = pg8::cvt_pk_bf16(v0[0], v0[1]); w.y = pg8::cvt_pk_bf16(v0[2], v0[3]); w.z = pg8::cvt_pk_bf16(v1[0], v1[1]); w.w = pg8::cvt_pk_bf16(v1[2], v1[3]);
                        *(GAS v4u*)(rowp + bj * 128) = w; } }
        } else {
            const bool odd = fr & 1;
            float rsc[2][8]; rs_rows8x16(rss, un.pm * 256 + c0, fr, 16 * fq + fr, rsc[0]); rs_rows8x16(rss, un.pm * 256 + c0 + 128, fr, 16 * fq + fr, rsc[1]);
            const float* cosT = rope + (size_t)2 * SEQ * 64; const float* sinT = rope + (size_t)3 * SEQ * 64;
#pragma unroll
            for (int ai = 0; ai < 2; ++ai)
#pragma unroll
                for (int m = 0; m < 4; ++m) { const int rr = r0 + ai * 128 + m * 16, fi = (rr & 127) >> 1;
                    bf16* rowp = kbT + (size_t)((un.pn - 54) * 256 + rr) * MT + un.pm * 256 + c0;
#pragma unroll
                    for (int bj = 0; bj < 2; ++bj) { const int t = (un.pm * 256 + c0 + bj * 128) & (SEQ - 1);
                        const f32x4 cA = *(const GAS f32x4*)(cosT + (size_t)fi * SEQ + t), cB = *(const GAS f32x4*)(cosT + (size_t)fi * SEQ + t + 4);
                        const f32x4 sA = *(const GAS f32x4*)(sinT + (size_t)fi * SEQ + t), sB = *(const GAS f32x4*)(sinT + (size_t)fi * SEQ + t + 4);
                        f32x4 v0 = acc[ai][bj][m][0], v1 = acc[ai][bj][m][1];
#pragma unroll
                        for (int e = 0; e < 4; ++e) { v0[e] *= rsc[bj][e]; v1[e] *= rsc[bj][4 + e]; }
                        float o[8];
#pragma unroll
                        for (int e = 0; e < 4; ++e) { const float p0 = shx(v0[e], 1, 16 * fq + fr), p1 = shx(v1[e], 1, 16 * fq + fr);
                            o[e]     = odd ? (p0 * sA[e] + v0[e] * cA[e]) : (v0[e] * cA[e] - p0 * sA[e]);
                            o[4 + e] = odd ? (p1 * sB[e] + v1[e] * cB[e]) : (v1[e] * cB[e] - p1 * sB[e]); }
                        v4u w; w.x = pg8::cvt_pk_bf16(o[0], o[1]); w.y = pg8::cvt_pk_bf16(o[2], o[3]); w.z = pg8::cvt_pk_bf16(o[4], o[5]); w.w = pg8::cvt_pk_bf16(o[6], o[7]);
                        *(GAS v4u*)(rowp + bj * 128) = w; asm volatile("" ::: "memory"); } }
        }
    }
};

struct SchedBr {
    const char* omix; const char* wt; int G, c;
    __device__ __forceinline__ bool next(int i, Unit& u) const {
        int pm, pn; if (!pg8::static_tile(32, 8, G, c, i / 3, pm, pn)) return false;
        u.pm = pm; u.pn = pn; u.kind = i % 3; return true;
    }
    __device__ __forceinline__ void ptrs(const Unit& u, const char*& a, const char*& b, int& nt) const {
        const int koff = (u.kind == 0) ? 0 : (u.kind == 1) ? 768 : 1792; nt = (u.kind == 1) ? 16 : 12;
        a = omix + ((size_t)u.pm * 256 * MIXW + koff) * 2; b = wt + ((size_t)u.pn * 256 * MIXW + koff) * 2;
    }
};
__device__ __forceinline__ float sigmoidf_(float x) { return __builtin_amdgcn_rcpf(1.0f + __builtin_amdgcn_exp2f(-x * LOG2E)); }
struct EpiBr {
    static constexpr bool PERM = true;
    const bf16* u; bf16* merged;
    __device__ __forceinline__ void operator()(const f32x4 (&acc)[2][2][4][2], const Unit& un, int wr, int wc, int fr, int fq) const {
        asm volatile("" : "+v"(fr), "+v"(fq));
        const int r0 = un.pm * 256 + wr * 64 + fr, c0 = un.pn * 256 + wc * 32 + 8 * fq;
        v4u gw, gwn, pw = {0u, 0u, 0u, 0u}, pwn = pw;
        { const size_t row = (size_t)r0; const int col = c0;
          gw = *(const GAS v4u*)(u + row * INW + U_SA + un.kind * DM + col);
          if (un.kind > 0) pw = *(const GAS v4u*)(merged + row * DM + col); }
#pragma unroll
        for (int i = 0; i < 16; ++i) { const int rg = i >> 1, bj = i & 1, ai = rg >> 2, m = rg & 3; const size_t row = (size_t)(r0 + ai * 128 + m * 16); const int col = c0 + bj * 128;
            if (i < 15) { const int rgn = (i + 1) >> 1, bjn = (i + 1) & 1; const size_t rown = (size_t)(r0 + (rgn >> 2) * 128 + (rgn & 3) * 16); const int coln = c0 + bjn * 128;
                gwn = *(const GAS v4u*)(u + rown * INW + U_SA + un.kind * DM + coln);
                if (un.kind > 0) pwn = *(const GAS v4u*)(merged + rown * DM + coln); }
            const f32x4 v0 = acc[ai][bj][m][0], v1 = acc[ai][bj][m][1];
            f32x4 o0, o1;
            o0[0] = sigmoidf_(bflo(gw.x)) * v0[0]; o0[1] = sigmoidf_(bfhi(gw.x)) * v0[1]; o0[2] = sigmoidf_(bflo(gw.y)) * v0[2]; o0[3] = sigmoidf_(bfhi(gw.y)) * v0[3];
            o1[0] = sigmoidf_(bflo(gw.z)) * v1[0]; o1[1] = sigmoidf_(bfhi(gw.z)) * v1[1]; o1[2] = sigmoidf_(bflo(gw.w)) * v1[2]; o1[3] = sigmoidf_(bfhi(gw.w)) * v1[3];
            if (un.kind > 0) { o0[0] += bflo(pw.x); o0[1] += bfhi(pw.x); o0[2] += bflo(pw.y); o0[3] += bfhi(pw.y); o1[0] += bflo(pw.z); o1[1] += bfhi(pw.z); o1[2] += bflo(pw.w); o1[3] += bfhi(pw.w); }
            v4u w; w.x = pg8::cvt_pk_bf16(o0[0], o0[1]); w.y = pg8::cvt_pk_bf16(o0[2], o0[3]); w.z = pg8::cvt_pk_bf16(o1[0], o1[1]); w.w = pg8::cvt_pk_bf16(o1[2], o1[3]);
            *(GAS v4u*)(merged + row * DM + col) = w;
            gw = gwn; pw = pwn; }
    }
};

struct SchedPlain {
    const char* A; const char* Bt; int nN, ld, nt, G, c;
    __device__ __forceinline__ bool next(int i, Unit& u) const { int pm, pn; if (!pg8::static_tile(32, nN, G, c, i, pm, pn)) return false; u.pm = pm; u.pn = pn; u.kind = 0; return true; }
    __device__ __forceinline__ void ptrs(const Unit& u, const char*& a, const char*& b, int& nt_) const { nt_ = nt; a = A + (size_t)u.pm * 256 * ld * 2; b = Bt + (size_t)u.pn * 256 * ld * 2; }
};
struct EpiResid {
    static constexpr bool PERM = true;
    const float* xf32; bf16* xhi; bf16* xlo; float* rss;
    __device__ __forceinline__ void operator()(const f32x4 (&acc)[2][2][4][2], const Unit& un, int wr, int wc, int fr, int fq) const {
        asm volatile("" : "+v"(fr), "+v"(fq));
        const int r0 = un.pm * 256 + wr * 64 + fr, c0 = un.pn * 256 + wc * 32 + 8 * fq, lane = 16 * fq + fr;
        float xa[2][8], xn_[2][8];
#define ER_LOAD(dst, row_) do { _Pragma("unroll") for (int bj = 0; bj < 2; ++bj) { const size_t o_ = (size_t)(row_) * DM + c0 + bj * 128; \
            if (xf32) { const f32x4 a_ = *(const GAS f32x4*)(xf32 + o_), b_ = *(const GAS f32x4*)(xf32 + o_ + 4); \
                dst[bj][0] = a_[0]; dst[bj][1] = a_[1]; dst[bj][2] = a_[2]; dst[bj][3] = a_[3]; dst[bj][4] = b_[0]; dst[bj][5] = b_[1]; dst[bj][6] = b_[2]; dst[bj][7] = b_[3]; } \
            else { const v4u h_ = *(const GAS v4u*)(xhi + o_); v4u l_ = {0u, 0u, 0u, 0u}; if (RESID_LO) l_ = *(const GAS v4u*)(xlo + o_); \
                dst[bj][0] = bflo(h_.x) + bflo(l_.x); dst[bj][1] = bfhi(h_.x) + bfhi(l_.x); dst[bj][2] = bflo(h_.y) + bflo(l_.y); dst[bj][3] = bfhi(h_.y) + bfhi(l_.y); \
                dst[bj][4] = bflo(h_.z) + bflo(l_.z); dst[bj][5] = bfhi(h_.z) + bfhi(l_.z); dst[bj][6] = bflo(h_.w) + bflo(l_.w); dst[bj][7] = bfhi(h_.w) + bfhi(l_.w); } } } while (0)
        ER_LOAD(xa, r0);
#pragma unroll
        for (int i = 0; i < 8; ++i) { const int ai = i >> 2, m = i & 3; const int row = r0 + ai * 128 + m * 16; float ss = 0.f;
            if (i < 7) ER_LOAD(xn_, r0 + ((i + 1) >> 2) * 128 + ((i + 1) & 3) * 16);
#pragma unroll
            for (int bj = 0; bj < 2; ++bj) { const size_t o_ = (size_t)row * DM + c0 + bj * 128; float v[8];
#pragma unroll
                for (int e = 0; e < 4; ++e) { v[e] = xa[bj][e] + acc[ai][bj][m][0][e]; v[4 + e] = xa[bj][4 + e] + acc[ai][bj][m][1][e]; }
#pragma unroll
                for (int e = 0; e < 8; ++e) ss += v[e] * v[e];
                v4u hw; hw.x = pg8::cvt_pk_bf16(v[0], v[1]); hw.y = pg8::cvt_pk_bf16(v[2], v[3]); hw.z = pg8::cvt_pk_bf16(v[4], v[5]); hw.w = pg8::cvt_pk_bf16(v[6], v[7]);
                v4u lw; lw.x = pg8::cvt_pk_bf16(v[0] - bflo(hw.x), v[1] - bfhi(hw.x)); lw.y = pg8::cvt_pk_bf16(v[2] - bflo(hw.y), v[3] - bfhi(hw.y));
                lw.z = pg8::cvt_pk_bf16(v[4] - bflo(hw.z), v[5] - bfhi(hw.z)); lw.w = pg8::cvt_pk_bf16(v[6] - bflo(hw.w), v[7] - bfhi(hw.w));
                *(GAS v4u*)(xhi + o_) = hw; if (RESID_LO) *(GAS v4u*)(xlo + o_) = lw; }
            ss += shx(ss, 16, lane); ss += shx(ss, 32, lane);
            if (fq == 0) ((GAS float*)rss)[(size_t)row * 32 + (un.pn & 7) * 4 + wc] = ss;
#pragma unroll
            for (int bj = 0; bj < 2; ++bj)
#pragma unroll
                for (int e = 0; e < 8; ++e) xa[bj][e] = xn_[bj][e]; }
#undef ER_LOAD
    }
};
struct EpiRelu2 {
    static constexpr bool PERM = true;
    bf16* h; const float* rss; mutable int pm_c = -1; mutable float rsv_c[8] = {};
    __device__ __forceinline__ void operator()(const f32x4 (&acc)[2][2][4][2], const Unit& un, int wr, int wc, int fr, int fq) const {
        asm volatile("" : "+v"(fr), "+v"(fq));
        const int r0 = un.pm * 256 + wr * 64 + fr, c0 = un.pn * 256 + wc * 32 + 8 * fq;
        if (pm_c != un.pm) { rs_rows_tile(rss, r0, fq, 16 * fq + fr, rsv_c); pm_c = un.pm; }
        const float (&rsv)[8] = rsv_c;
#pragma unroll
        for (int ai = 0; ai < 2; ++ai)
#pragma unroll
            for (int m = 0; m < 4; ++m) { bf16* rowp = h + (size_t)(r0 + ai * 128 + m * 16) * FF + c0; const float rs = rsv[ai * 4 + m];
#pragma unroll
                for (int bj = 0; bj < 2; ++bj) { f32x4 v0 = acc[ai][bj][m][0] * rs, v1 = acc[ai][bj][m][1] * rs;
#pragma unroll
                    for (int e = 0; e < 4; ++e) { const float a = v0[e] > 0.f ? v0[e] : 0.f, b = v1[e] > 0.f ? v1[e] : 0.f; v0[e] = a * a; v1[e] = b * b; }
                    v4u w; w.x = pg8::cvt_pk_bf16(v0[0], v0[1]); w.y = pg8::cvt_pk_bf16(v0[2], v0[3]); w.z = pg8::cvt_pk_bf16(v1[0], v1[1]); w.w = pg8::cvt_pk_bf16(v1[2], v1[3]);
                    *(GAS v4u*)(rowp + bj * 128) = w; } }
    }
};
struct SchedCross {
    const char* xn; const char* wq; const char* mn; const char* wkv; int G, c;
    __device__ __forceinline__ bool next(int i, Unit& u) const {
        const int L = i * G + c; if (L >= 72) return false;
        if (L < 64) { u.pm = L >> 1; u.pn = L & 1; u.kind = 0; }
        else { u.pm = (L - 64) & 1; u.pn = (L - 64) >> 1; u.kind = 1; }
        return true;
    }
    __device__ __forceinline__ void ptrs(const Unit& u, const char*& a, const char*& b, int& nt) const {
        nt = DM / 64;
        if (u.kind == 0) { a = xn + (size_t)u.pm * TSTEP_DM; b = wq + (size_t)u.pn * TSTEP_DM; }
        else { a = mn + (size_t)u.pm * TSTEP_DM; b = wkv + (size_t)u.pn * TSTEP_DM; }
    }
};
struct EpiCross {
    static constexpr bool PERM = true;
    bf16* qx; bf16* kx; bf16* vxT; const float* rss;
    __device__ __forceinline__ void operator()(const f32x4 (&acc)[2][2][4][2], const Unit& un, int wr, int wc, int fr, int fq) const {
        asm volatile("" : "+v"(fr), "+v"(fq));
        bf16* base = (un.kind == 0) ? qx : kx; const int ldo = (un.kind == 0) ? CRW : 2 * CRW;
        const int r0 = un.pm * 256 + wr * 64 + fr, c0 = un.pn * 256 + wc * 32 + 8 * fq;
        float rsv[8]; rs_rows_tile(rss, (un.kind == 0) ? r0 : wr * 64 + fr, fq, 16 * fq + fr, rsv);
#pragma unroll
        for (int ai = 0; ai < 2; ++ai)
#pragma unroll
            for (int m = 0; m < 4; ++m) { bf16* rowp = base + (size_t)(r0 + ai * 128 + m * 16) * ldo + c0;
                const float rs = (un.kind == 0) ? rsv[ai * 4 + m] : 1.0f;
#pragma unroll
                for (int bj = 0; bj < 2; ++bj) { const f32x4 v0 = acc[ai][bj][m][0] * rs, v1 = acc[ai][bj][m][1] * rs;
                    v4u w; w.x = pg8::cvt_pk_bf16(v0[0], v0[1]); w.y = pg8::cvt_pk_bf16(v0[2], v0[3]); w.z = pg8::cvt_pk_bf16(v1[0], v1[1]); w.w = pg8::cvt_pk_bf16(v1[2], v1[3]);
                    *(GAS v4u*)(rowp + bj * 128) = w; } }
    }
};

__device__ __forceinline__ void lds_barrier() { asm volatile("s_waitcnt lgkmcnt(0)" ::: "memory"); __builtin_amdgcn_s_barrier(); asm volatile("" ::: "memory"); }
__device__ __forceinline__ unsigned off_b(unsigned row, unsigned ch) { return 256u * row + 16u * (ch ^ (((row & 3) << 2) | ((row >> 2) & 3))); }
__device__ __forceinline__ unsigned tr_read_addr_16(unsigned lane, unsigned c, unsigned t) {
    const unsigned g = lane >> 4, q = (lane & 15) >> 2, p = lane & 3;
    return off_b(8 * g + 4 * t + q, 2 * c + (p >> 1)) + 8 * (p & 1);
}
__device__ __forceinline__ s16x4 tr_read(LAS unsigned char* p) { return __builtin_amdgcn_ds_read_tr16_b64_v4i16((LAS s16x4*)p); }

struct AttnState { f32x4 o[8]; float m, l; };
__device__ __forceinline__ void attn_softmax_step(AttnState& A, float (&x)[8], unsigned vmask, bf16x8& bp, int lane) {
    float mx = -1e30f;
#pragma unroll
    for (int e = 0; e < 8; ++e) { x[e] = ((vmask >> e) & 1u) ? x[e] : -1e30f; mx = fmaxf(mx, x[e]); }
    mx = fmaxf(mx, shx(mx, 16, lane)); mx = fmaxf(mx, shx(mx, 32, lane));
    if (__builtin_amdgcn_ballot_w64(mx > A.m + 8.0f) != 0ull) {
        const float mn = fmaxf(A.m, mx), alpha = __builtin_amdgcn_exp2f(A.m - mn);
        A.l *= alpha; A.m = mn;
#pragma unroll
        for (int c = 0; c < 8; ++c) A.o[c] *= alpha;
    }
    float p[8], sum = 0.f;
#pragma unroll
    for (int e = 0; e < 8; ++e) { p[e] = ((vmask >> e) & 1u) ? __builtin_amdgcn_exp2f(x[e] - A.m) : 0.f; sum += p[e]; }
    sum += shx(sum, 16, lane); sum += shx(sum, 32, lane);
    A.l += sum;
    bp = pack8(p);
}
__device__ __forceinline__ int t5_bucket_dev(int rel) {
    const int n = rel < 0 ? -rel : rel; int b;
    if (n < 8) b = n; else b = 8 + (n >= 15) + (n >= 27) + (n >= 50) + (n >= 91) + (n >= 166) + (n >= 305) + (n >= 559);
    return b + (rel > 0 ? 16 : 0);
}

__device__ __forceinline__ void load_mixer_tables(Frame& F, const float* rpb_l, const float* t5_bias) {
    LAS float* rpb2 = (LAS float*)(F.lds + LDS_RPB); LAS float* t5b2 = (LAS float*)(F.lds + LDS_T5);
    for (int i = (F.wave * 64 + lane_id()); i < 6 * 15 * 31; i += NWAVES * 64) rpb2[i] = ((const GAS float*)rpb_l)[i] * LOG2E;
    for (int i = (F.wave * 64 + lane_id()); i < 6 * 3 * 129; i += NWAVES * 64) { const int h = i / 387, r = i % 387, gv = r / 129, jj = r % 129; const int d = (gv == 0) ? 1 : (gv == 1) ? 4 : 16;
        t5b2[i] = ((const GAS float*)t5_bias)[t5_bucket_dev(d * (jj - 64)) * 6 + h] * LOG2E; }
    __syncthreads();
}

constexpr int BLA_STAGE = 32768;
struct BlaLoad { bf16x8 k[2], v[2]; };
__device__ __forceinline__ void bla_issue(BlaLoad& L, rsrc_t rK, rsrc_t rV, unsigned voffK, unsigned voffV, unsigned soffK, unsigned soffV) {
    L.k[0] = ldb8(rK, voffK, soffK); L.k[1] = ldb8(rK, voffK + 16u, soffK); L.v[0] = ldb8(rV, voffV, soffV); L.v[1] = ldb8(rV, voffV + 16u, soffV);
}
__device__ __forceinline__ void bla_write(const BlaLoad& L, LAS unsigned char* st, int tid) {
    const unsigned row = tid >> 3, c0 = 2 * (tid & 7);
    *(LAS bf16x8*)(st + off_b(row, c0)) = L.k[0]; *(LAS bf16x8*)(st + off_b(row, c0 + 1)) = L.k[1];
    *(LAS bf16x8*)(st + 16384 + off_b(row, c0)) = L.v[0]; *(LAS bf16x8*)(st + 16384 + off_b(row, c0 + 1)) = L.v[1];
}
template <class LI>
__device__ __forceinline__ void bla_substep(AttnState& A, const bf16x8 (&bq)[4], const LAS unsigned char* st, int wo, int lane, const LAS float* tab, const LI& li_) {
    const int g = lane >> 4, li = lane & 15;
    const unsigned row0 = wo + 8 * (li >> 2) + (li & 3);
    const unsigned Xa = ((li & 3) << 2) | (((wo >> 2) + 2 * (li >> 2)) & 3), Xb = ((li & 3) << 2) | (((wo >> 2) + 2 * (li >> 2) + 1) & 3);
    bf16x8 a0[4], a1[4];
#pragma unroll
    for (int ks = 0; ks < 4; ++ks) { a0[ks] = *(const LAS bf16x8*)(st + 256u * row0 + 16u * ((4 * ks + g) ^ Xa)); a1[ks] = *(const LAS bf16x8*)(st + 256u * (row0 + 4) + 16u * ((4 * ks + g) ^ Xb)); }
    float bb[8]; unsigned vmask = 0u;
#pragma unroll
    for (int e = 0; e < 8; ++e) { bool valid; const int ix = li_(e, valid); bb[e] = tab ? tab[ix] : 0.f; vmask |= valid ? (1u << e) : 0u; }
    const unsigned q = (lane & 15) >> 2, p = lane & 3;
    const unsigned X0 = (q << 2) | (((wo >> 2) + 2 * g) & 3), X1 = (q << 2) | (((wo >> 2) + 2 * g + 1) & 3);
    const unsigned rb0 = 16384u + 256u * (wo + 8 * g + q) + 16u * ((p >> 1) ^ (X0 & 1)) + 8u * (p & 1), rx0 = X0 >> 1;
    const unsigned rb1 = 16384u + 256u * (wo + 8 * g + 4 + q) + 16u * ((p >> 1) ^ (X1 & 1)) + 8u * (p & 1), rx1 = X1 >> 1;
    s16x4 tv0[8], tv1[8];
#pragma unroll
    for (int c = 0; c < 8; ++c) { tv0[c] = tr_read((LAS unsigned char*)st + rb0 + ((c ^ rx0) << 5)); tv1[c] = tr_read((LAS unsigned char*)st + rb1 + ((c ^ rx1) << 5)); }
    f32x4 st0 = (f32x4){0.f, 0.f, 0.f, 0.f}, st1 = st0;
#pragma unroll
    for (int ks = 0; ks < 4; ++ks) { st0 = MFMA16(a0[ks], bq[ks], st0); st1 = MFMA16(a1[ks], bq[ks], st1); }
    float x[8], mx = -1e30f;
#pragma unroll
    for (int e = 0; e < 8; ++e) { x[e] = ((vmask >> e) & 1u) ? ((e < 4) ? st0[e & 3] : st1[e & 3]) + bb[e] : -1e30f; mx = fmaxf(mx, x[e]); }
    if (__builtin_amdgcn_ballot_w64(mx > A.m + 8.0f) != 0ull) {
        mx = fmaxf(mx, shx(mx, 16, lane)); mx = fmaxf(mx, shx(mx, 32, lane));
        const float mn = fmaxf(A.m, mx), alpha = __builtin_amdgcn_exp2f(A.m - mn);
        A.l *= alpha; A.m = mn;
#pragma unroll
        for (int c = 0; c < 8; ++c) A.o[c] *= alpha;
    }
    float pr[8], sum = 0.f;
#pragma unroll
    for (int e = 0; e < 8; ++e) { pr[e] = ((vmask >> e) & 1u) ? __builtin_amdgcn_exp2f(x[e] - A.m) : 0.f; sum += pr[e]; }
    A.l += sum;
    const bf16x8 bp = pack8(pr);
#pragma unroll
    for (int c = 0; c < 8; ++c) {
        bf16x8 a; a[0] = tv0[c][0]; a[1] = tv0[c][1]; a[2] = tv0[c][2]; a[3] = tv0[c][3]; a[4] = tv1[c][0]; a[5] = tv1[c][1]; a[6] = tv1[c][2]; a[7] = tv1[c][3];
        A.o[c] = MFMA16(a, bp, A.o[c]);
    }
}
__device__ __forceinline__ float bla_rowsum(const AttnState& A, int lane) { float l = A.l; l += shx(l, 16, lane); l += shx(l, 32, lane); return l; }
template <class VO, class CP>
__device__ __forceinline__ void bla_pipeline(LAS unsigned char* lds, int tid, int NT, rsrc_t rK, rsrc_t rV, unsigned soffK, unsigned soffV, const VO& voffs, const CP& compute) {
    BlaLoad LA, LB; unsigned vK, vV;
    voffs(0, vK, vV); bla_issue(LA, rK, rV, vK, vV, soffK, soffV);
    if (NT > 1) { voffs(1, vK, vV); bla_issue(LB, rK, rV, vK, vV, soffK, soffV); }
    bla_write(LA, lds, tid);
    if (NT > 2) { voffs(2, vK, vV); bla_issue(LA, rK, rV, vK, vV, soffK, soffV); }
    lds_barrier();
    for (int t = 0; t < NT; t += 2) {
        if (t + 1 < NT) bla_write(LB, lds + BLA_STAGE, tid);
        if (t + 3 < NT) { voffs(t + 3, vK, vV); bla_issue(LB, rK, rV, vK, vV, soffK, soffV); }
        compute(t, (const LAS unsigned char*)lds);
        lds_barrier();
        if (t + 1 < NT) {
            if (t + 2 < NT) bla_write(LA, lds, tid);
            if (t + 4 < NT) { voffs(t + 4, vK, vV); bla_issue(LA, rK, rV, vK, vV, soffK, soffV); }
            compute(t + 1, (const LAS unsigned char*)(lds + BLA_STAGE));
            lds_barrier();
        }
    }
}

__device__ __forceinline__ void na_unit(Frame& F, int unit, const bf16* u, bf16* omix) {
    const LAS float* rpb2 = (const LAS float*)(F.lds + LDS_RPB);
    int lane = lane_id(); asm volatile("" : "+v"(lane)); const int g = lane >> 4, li = lane & 15, w = F.wave, tid = w * 64 + lane;
    const int rp = unit & 31, h = (unit >> 5) % 6, b = unit / 192;
    const int r = 2 * rp + (w >> 2), j = w & 3, qi = 16 * j + li;
    const size_t tq = (size_t)b * SEQ + r * 64 + qi;
    const int R0 = min(max(2 * rp - 4, 0), 56), R1 = min(max(2 * rp - 3, 0), 56), NT = R1 + 8 - R0;
    const int r0w = min(max(r - 4, 0), 56), cl = min(max(16 * j - 8, 0), 32), c0q = min(max(qi - 8, 0), 48);
    const rsrc_t rU = mk_rsrc(u, SZ_U);
    bf16x8 bq[4];
#pragma unroll
    for (int ks = 0; ks < 4; ++ks) bq[ks] = ldb8(rU, (unsigned)(qi * INW + 8 * g) * 2u, (unsigned)((((size_t)b * SEQ + r * 64) * INW + U_QA + h * 128 + 32 * ks) * 2));
    AttnState A;
#pragma unroll
    for (int c = 0; c < 8; ++c) A.o[c] = (f32x4){0.f, 0.f, 0.f, 0.f};
    A.m = -1e30f; A.l = 0.f;
    const LAS float* rp_ = rpb2 + h * 465;
    const unsigned vrow = (unsigned)((tid >> 3) * INW) * 2u + 32u * (tid & 7);
    const unsigned sbase = (unsigned)((((size_t)b * SEQ + R0 * 64) * INW + h * 128) * 2);
    bla_pipeline(F.lds, tid, NT, rU, rU, sbase + U_KA * 2, sbase + U_VA * 2,
        [&](int t, unsigned& vK, unsigned& vV) { vK = vV = vrow + (unsigned)(t * 64 * INW) * 2u; },
        [&](int t, const LAS unsigned char* st) { const int kr = R0 + t;
            if (kr >= r0w && kr < r0w + 8)
                bla_substep(A, bq, st, cl, lane, rp_, [&](int e, bool& valid) { const int kc = cl + 8 * g + e; valid = (kc >= c0q) && (kc < c0q + 16);
                    return valid ? ((kr - r + 7) * 31 + (kc - qi + 15)) : 0; }); });
    const float inv = 1.0f / bla_rowsum(A, lane);
    bf16* op = omix + tq * MIXW + h * 128 + 4 * g;
#pragma unroll
    for (int c = 0; c < 8; ++c) { v2u wv; wv.x = pk2(A.o[c][0] * inv, A.o[c][1] * inv); wv.y = pk2(A.o[c][2] * inv, A.o[c][3] * inv); *(GAS v2u*)(op + 16 * c) = wv; }
}

template <int VIEW>
__device__ __forceinline__ void dil_unit(Frame& F, int unit, const bf16* u, bf16* po, float* pl) {
    constexpr int DD = (VIEW == 0) ? 1 : (VIEW == 1) ? 4 : 16, DL = SEQ / DD, BPC = DL / 128;
    const LAS float* t5b2 = (const LAS float*)(F.lds + LDS_T5);
    int lane = lane_id(); asm volatile("" : "+v"(lane)); const int g = lane >> 4, li = lane & 15, w = F.wave, tid = w * 64 + lane;
    const int blk = unit & 31, h = (unit >> 5) % 6, b = unit / 192;
    const int rho = blk / BPC, P0 = 128 * (blk % BPC), KP0 = P0 - 64;
    const int qp = P0 + 16 * w + li;
    const size_t tb = (size_t)b * SEQ + rho, tq = tb + (size_t)DD * qp;
    const rsrc_t rU = mk_rsrc(u, SZ_U);
    bf16x8 bq[4];
#pragma unroll
    for (int ks = 0; ks < 4; ++ks) bq[ks] = ldb8(rU, (unsigned)((size_t)DD * (16 * w + li) * INW + 8 * g) * 2u, (unsigned)(((tb + (size_t)DD * P0) * INW + U_QC + h * 128 + 32 * ks) * 2));
    AttnState A;
#pragma unroll
    for (int c = 0; c < 8; ++c) A.o[c] = (f32x4){0.f, 0.f, 0.f, 0.f};
    A.m = -1e30f; A.l = 0.f;
    const LAS float* bias = t5b2 + (h * 3 + VIEW) * 129;
    const unsigned sbase = (unsigned)((tb * INW + h * 128) * 2);
    const int s_lo = w >> 1;
    bla_pipeline(F.lds, tid, 4, rU, rU, sbase + U_KC * 2, sbase + U_VC * 2,
        [&](int t, unsigned& vK, unsigned& vV) { const int kp = min(max(KP0 + 64 * t + (tid >> 3), 0), DL - 1); vK = vV = (unsigned)((size_t)DD * kp * INW) * 2u + 32u * (tid & 7); },
        [&](int t, const LAS unsigned char* st) {
#pragma unroll
            for (int hf = 0; hf < 2; ++hf) { const int ss = 2 * t + hf;
                if (ss >= s_lo && ss <= s_lo + 4)
                    bla_substep(A, bq, st, 32 * hf, lane, bias, [&](int e, bool& valid) { const int kp = KP0 + 32 * ss + 8 * g + e, dl = kp - qp; valid = (kp >= 0) && (kp < DL) && (dl >= -64) && (dl <= 64);
                        return valid ? dl + 64 : 0; }); } });
    const float lsum = bla_rowsum(A, lane), inv = 1.0f / lsum, lse = A.m + __builtin_amdgcn_logf(lsum);
    bf16* pp = po + ((size_t)VIEW * MT + tq) * 768 + h * 128 + 4 * g;
#pragma unroll
    for (int c = 0; c < 8; ++c) { v2u wv; wv.x = pk2(A.o[c][0] * inv, A.o[c][1] * inv); wv.y = pk2(A.o[c][2] * inv, A.o[c][3] * inv); *(GAS v2u*)(pp + 16 * c) = wv; }
    if (g == 0) ((GAS float*)pl)[((size_t)VIEW * MT + tq) * 8 + h] = lse;
}
__device__ __forceinline__ void combine_tasks(Frame& F, const bf16* po, const float* pl, bf16* omix) {
    int lane = lane_id(); asm volatile("" : "+v"(lane));
    for (int task = opq(F.gw); task < MT * 6; task += opq(F.ngw)) {
        const int h = task % 6; const size_t tq = task / 6;
        const float l1 = ((const GAS float*)pl)[tq * 8 + h], l4 = ((const GAS float*)pl)[((size_t)MT + tq) * 8 + h], l16 = ((const GAS float*)pl)[((size_t)2 * MT + tq) * 8 + h];
        const float mx = fmaxf(l1, fmaxf(l4, l16));
        const float w1 = __builtin_amdgcn_exp2f(l1 - mx), w4 = __builtin_amdgcn_exp2f(l4 - mx), w16 = __builtin_amdgcn_exp2f(l16 - mx), wi = 1.0f / (w1 + w4 + w16);
        const size_t off = tq * 768 + h * 128 + 2 * lane;
        const unsigned ua = *(const GAS unsigned*)(po + off), ub = *(const GAS unsigned*)(po + (size_t)MT * 768 + off), uc = *(const GAS unsigned*)(po + (size_t)2 * MT * 768 + off);
        const f32x2 a = {bflo(ua), bfhi(ua)}, b4 = {bflo(ub), bfhi(ub)}, c16 = {bflo(uc), bfhi(uc)};
        const f32x2 o = (a * w1 + b4 * w4 + c16 * w16) * wi;
        *(GAS unsigned*)(omix + tq * MIXW + 1792 + h * 128 + 2 * lane) = pk2(o[0], o[1]);
    }
}

template <class LD, class IS, class WR, class CP>
__device__ __forceinline__ void tile_pipeline(LAS unsigned char* lds, const int stage_bytes, const int NT, const IS& issue, const WR& write, const CP& compute) {
    LD LA, LB;
    issue(0, LA); if (NT > 1) issue(1, LB);
    write(LA, lds); if (NT > 2) issue(2, LA);
    lds_barrier();
    for (int t = 0; t < NT; t += 2) {
        if (t + 1 < NT) write(LB, lds + stage_bytes);
        if (t + 3 < NT) issue(t + 3, LB);
        compute(t, (const LAS unsigned char*)lds);
        lds_barrier();
        if (t + 1 < NT) {
            if (t + 2 < NT) write(LA, lds);
            if (t + 4 < NT) issue(t + 4, LA);
            compute(t + 1, (const LAS unsigned char*)(lds + stage_bytes));
            lds_barrier();
        }
    }
}
struct RowTile { bf16x8 c[4]; };
__device__ __forceinline__ void rowtile_issue(RowTile& L, rsrc_t r, unsigned voff, unsigned soff) {
#pragma unroll
    for (int j = 0; j < 4; ++j) L.c[j] = ldb8(r, voff + 16u * j, soff);
}
__device__ __forceinline__ void rowtile_write(const RowTile& L, LAS unsigned char* st, int tid) {
    const unsigned row = tid >> 2, c0 = 4 * (tid & 3);
#pragma unroll
    for (int j = 0; j < 4; ++j) *(LAS bf16x8*)(st + off_b(row, c0 + j)) = L.c[j];
}
__device__ __forceinline__ bf16x8 lds_frag(const LAS unsigned char* st, unsigned row, unsigned ch) { return *(const LAS bf16x8*)(st + off_b(row, ch)); }

struct MgLoad { RowTile a, b; };
constexpr int MG_STAGE = 65536;
__device__ __forceinline__ void mini_gemm(LAS unsigned char* lds, int tid, int w, int lane, rsrc_t rA, rsrc_t rB, unsigned pitchA_b, unsigned pitchB_b, unsigned sA, unsigned sB, int npieces, f32x4 (&acc)[2][4]) {
    const int g = lane >> 4, li = lane & 15, rgp = w >> 1, chh = w & 1;
    const unsigned voA = (unsigned)(tid >> 2) * pitchA_b + 64u * (tid & 3), voB = (unsigned)(tid >> 2) * pitchB_b + 64u * (tid & 3);
#pragma unroll
    for (int rt = 0; rt < 2; ++rt)
#pragma unroll
        for (int c = 0; c < 4; ++c) acc[rt][c] = (f32x4){0.f, 0.f, 0.f, 0.f};
    tile_pipeline<MgLoad>(lds, MG_STAGE, npieces,
        [&](int t, MgLoad& L) { rowtile_issue(L.a, rA, voA, sA + 256u * t); rowtile_issue(L.b, rB, voB, sB + 256u * t); },
        [&](const MgLoad& L, LAS unsigned char* st) { rowtile_write(L.a, st, tid); rowtile_write(L.b, st + 32768, tid); },
        [&](int t, const LAS unsigned char* st) {
#pragma unroll
            for (int ks = 0; ks < 4; ++ks) { const bf16x8 a0 = lds_frag(st, 32 * rgp + li, 4 * ks + g), a1 = lds_frag(st, 32 * rgp + 16 + li, 4 * ks + g);
#pragma unroll
                for (int c = 0; c < 4; ++c) { const bf16x8 bb = lds_frag(st + 32768, 64 * chh + 16 * c + li, 4 * ks + g); acc[0][c] = MFMA16(bb, a0, acc[0][c]); acc[1][c] = MFMA16(bb, a1, acc[1][c]); } } });
}
__device__ __forceinline__ void kvproj_unit(Frame& F, int unit, const bf16* mn, const bf16* wkv, bf16* kv) {
    int lane = lane_id(); asm volatile("" : "+v"(lane)); const int g = lane >> 4, li = lane & 15, w = F.wave, tid = w * 64 + lane;
    const int l = unit >> 5, mt = (unit >> 3) & 3, ct = unit & 7;
    const rsrc_t rA = mk_rsrc(mn, SZ_MN), rB = mk_rsrc(wkv, SZ_WCKV);
    f32x4 acc[2][4];
    mini_gemm(F.lds, tid, w, lane, rA, rB, DM * 2, DM * 2, (unsigned)(((size_t)l * MEMT + 128 * mt) * DM * 2), (unsigned)(((size_t)l * 2 * CRW + 128 * ct) * DM * 2), DM / 128, acc);
    bf16* out = kv + (size_t)l * MEMT * 2 * CRW;
#pragma unroll
    for (int rt = 0; rt < 2; ++rt)
#pragma unroll
        for (int c = 0; c < 4; ++c) { const int row = 128 * mt + 32 * (w >> 1) + 16 * rt + li, col = 128 * ct + 64 * (w & 1) + 16 * c + 4 * g;
            v2u wv; wv.x = pk2(acc[rt][c][0], acc[rt][c][1]); wv.y = pk2(acc[rt][c][2], acc[rt][c][3]); *(GAS v2u*)(out + (size_t)row * 2 * CRW + col) = wv; }
}
__device__ __forceinline__ void cross_unit(Frame& F, int unit, const bf16* xb, const bf16* wq, const float* rss, const bf16* kv, bf16* ax) {
    int lane = lane_id(); asm volatile("" : "+v"(lane)); const int g = lane >> 4, li = lane & 15, w = F.wave, tid = w * 64 + lane;
    const int qb = unit & 31, h = (unit >> 5) & 3, b = unit >> 7;
    const size_t t0 = (size_t)b * SEQ + 128 * qb;
    const rsrc_t rX = mk_rsrc(xb, SZ_XN), rW = mk_rsrc(wq, (size_t)CRW * DM * 2), rKV = mk_rsrc(kv, (size_t)MEMT * 2 * CRW * 2);
    LAS unsigned char* qt = F.lds + 98304;
    { f32x4 acc[2][4];
      mini_gemm(F.lds, tid, w, lane, rX, rW, DM * 2, DM * 2, (unsigned)(t0 * DM * 2), (unsigned)((size_t)(h * 128) * DM * 2), DM / 128, acc);
#pragma unroll
      for (int rt = 0; rt < 2; ++rt) { const int row = 32 * (w >> 1) + 16 * rt + li; const float rs = rs_row4(rss, (int)t0 + row, g, lane);
#pragma unroll
          for (int c = 0; c < 4; ++c) { const int col = 64 * (w & 1) + 16 * c + 4 * g; const f32x4 v = acc[rt][c] * rs;
              v2u wv; wv.x = pk2(v[0], v[1]); wv.y = pk2(v[2], v[3]); *(LAS v2u*)(qt + off_b(row, col >> 3) + 2 * (col & 7)) = wv; } } }
    lds_barrier();
    bf16x8 bq[4];
#pragma unroll
    for (int ks = 0; ks < 4; ++ks) bq[ks] = lds_frag(qt, 16 * w + li, 4 * ks + g);
    const size_t tq = t0 + 16 * w + li;
    AttnState A;
#pragma unroll
    for (int c = 0; c < 8; ++c) A.o[c] = (f32x4){0.f, 0.f, 0.f, 0.f};
    A.m = -1e30f; A.l = 0.f;
    const unsigned vrow = (unsigned)((tid >> 3) * 2 * CRW) * 2u + 32u * (tid & 7);
    const unsigned sbase = (unsigned)(((size_t)b * MEML * 2 * CRW + h * 128) * 2);
    bla_pipeline(F.lds, tid, 4, rKV, rKV, sbase, sbase + CRW * 2,
        [&](int t, unsigned& vK, unsigned& vV) { vK = vV = vrow + (unsigned)(t * 64 * 2 * CRW) * 2u; },
        [&](int t, const LAS unsigned char* st) {
#pragma unroll
            for (int hf = 0; hf < 2; ++hf) bla_substep(A, bq, st, 32 * hf, lane, (const LAS float*)nullptr, [&](int e, bool& valid) { valid = true; return 0; }); });
    const float inv = 1.0f / bla_rowsum(A, lane);
    bf16* op = ax + tq * CRW + h * 128 + 4 * g;
#pragma unroll
    for (int c = 0; c < 8; ++c) { v2u wv; wv.x = pk2(A.o[c][0] * inv, A.o[c][1] * inv); wv.y = pk2(A.o[c][2] * inv, A.o[c][3] * inv); *(GAS v2u*)(op + 16 * c) = wv; }
}

struct ScanLoad { RowTile k; bf16x8 v; };
constexpr int SCAN_STAGE = 32768 + 4096;
__device__ __forceinline__ void scan_unit(Frame& F, int unit, const bf16* kbT, const bf16* vbT, bf16* states, const float* decay_l) {
    int lane = lane_id(); asm volatile("" : "+v"(lane)); const int g = lane >> 4, li = lane & 15, a = F.wave, tid = a * 64 + lane;
    const int cs = unit & 15, grp = unit >> 4, dir = grp >> 3, b = (grp >> 2) & 1, h = grp & 3;
    const float lg2 = -__expf(((const GAS float*)decay_l)[dir * 4 + h]) * LOG2E;
    const float gc = __builtin_amdgcn_exp2f(128.f * lg2);
    float wv[8];
#pragma unroll
    for (int e = 0; e < 8; ++e) { const int jt = 8 * (tid & 15) + e; wv[e] = __builtin_amdgcn_exp2f((dir == 0 ? (float)(127 - jt) : (float)jt) * lg2); }
    const rsrc_t rK = mk_rsrc(kbT, SZ_KBT), rV = mk_rsrc(vbT, SZ_VBT);
    const unsigned voK = (unsigned)((tid >> 2) * MT) * 2u + 64u * (tid & 3), voV = (unsigned)(((tid >> 4) & 15) * MT) * 2u + 16u * (tid & 15);
    const unsigned sK = (unsigned)(((size_t)(h * 128) * MT + (size_t)b * SEQ) * 2), sV = (unsigned)(((size_t)(h * 256 + 16 * cs) * MT + (size_t)b * SEQ) * 2);
    bf16* sp = states + ((size_t)((dir * 2 + b) * 4 + h) * 32) * (256 * 128) + (size_t)(16 * cs + li) * 128 + 16 * a + 4 * g;
    f32x4 acc = (f32x4){0.f, 0.f, 0.f, 0.f};
    tile_pipeline<ScanLoad>(F.lds, SCAN_STAGE, 32,
        [&](int t, ScanLoad& L) { const int ch = (dir == 0) ? t : 31 - t; rowtile_issue(L.k, rK, voK, sK + (unsigned)(ch * 128) * 2u); if (a < 4) L.v = ldb8(rV, voV, sV + (unsigned)(ch * 128) * 2u); },
        [&](const ScanLoad& L, LAS unsigned char* st) { rowtile_write(L.k, st, tid);
            if (a < 4) { const v4u vr = __builtin_bit_cast(v4u, L.v); float vw[8];
                vw[0] = bflo(vr.x) * wv[0]; vw[1] = bfhi(vr.x) * wv[1]; vw[2] = bflo(vr.y) * wv[2]; vw[3] = bfhi(vr.y) * wv[3];
                vw[4] = bflo(vr.z) * wv[4]; vw[5] = bfhi(vr.z) * wv[5]; vw[6] = bflo(vr.w) * wv[6]; vw[7] = bfhi(vr.w) * wv[7];
                *(LAS bf16x8*)(st + 32768 + off_b((tid >> 4) & 15, tid & 15)) = pack8(vw); } },
        [&](int t, const LAS unsigned char* st) { const int ch = (dir == 0) ? t : 31 - t;
            { v2u w2; w2.x = pk2(acc[0], acc[1]); w2.y = pk2(acc[2], acc[3]); *(GAS v2u*)(sp + (size_t)ch * (256 * 128)) = w2; }
            acc *= gc;
            bf16x8 ka[4], vb[4];
#pragma unroll
            for (int ks = 0; ks < 4; ++ks) { ka[ks] = lds_frag(st, 16 * a + li, 4 * ks + g); vb[ks] = lds_frag(st + 32768, li, 4 * ks + g); }
#pragma unroll
            for (int ks = 0; ks < 4; ++ks) acc = MFMA16(ka[ks], vb[ks], acc); });
}

template <int T>
__device__ __forceinline__ void ro_piece(const LAS unsigned char* st, f32x4 (&tot)[16], const bf16x8 (&bq)[4], bf16x8 (&bp)[4], int lane, int iq, float xf, float xb, float lf, float lb) {
    const int g = lane >> 4, li = lane & 15;
    if constexpr (T < 4) {
#pragma unroll
        for (int c = 0; c < 8; ++c) { f32x4 t = (f32x4){0.f, 0.f, 0.f, 0.f};
#pragma unroll
            for (int ks = 0; ks < 4; ++ks) t = MFMA16(lds_frag(st, 16 * c + li, 4 * ks + g), bq[ks], t);
            if constexpr (T < 2) tot[8 * (T & 1) + c] = t * xf; else tot[8 * (T & 1) + c] += t * xb; }
    } else if constexpr (T == 4) {
#pragma unroll
        for (int s_ = 0; s_ < 4; ++s_) { f32x4 st0 = (f32x4){0.f, 0.f, 0.f, 0.f}, st1 = st0; const unsigned r0 = 32 * s_ + 8 * (li >> 2) + (li & 3);
#pragma unroll
            for (int ks = 0; ks < 4; ++ks) { st0 = MFMA16(lds_frag(st, r0, 4 * ks + g), bq[ks], st0); st1 = MFMA16(lds_frag(st, r0 + 4, 4 * ks + g), bq[ks], st1); }
            float p[8];
#pragma unroll
            for (int e = 0; e < 8; ++e) { const int jk = 32 * s_ + 8 * g + e, df = iq - jk;
                const float dm = (df >= 0) ? __builtin_amdgcn_exp2f((float)df * lf) : __builtin_amdgcn_exp2f((float)(-df) * lb); p[e] = ((e < 4) ? st0[e & 3] : st1[e & 3]) * dm; }
            bp[s_] = pack8(p); }
    } else {
#pragma unroll
        for (int c = 0; c < 8; ++c)
#pragma unroll
            for (int s_ = 0; s_ < 4; ++s_) tot[8 * (T - 5) + c] = MFMA16(lds_frag(st, 16 * c + li, 4 * s_ + g), bp[s_], tot[8 * (T - 5) + c]);
    }
}
__device__ __forceinline__ void retout_unit(Frame& F, int unit, const bf16* u, const bf16* vbT, const bf16* states, const float* decay_l, bf16* omix) {
    int lane = lane_id(); asm volatile("" : "+v"(lane)); const int g = lane >> 4, li = lane & 15, w = F.wave, tid = w * 64 + lane;
    const int ch = unit & 31, h = (unit >> 5) & 3, b = unit >> 7;
    const rsrc_t rS = mk_rsrc(states, SZ_ST), rU = mk_rsrc(u, SZ_U), rV = mk_rsrc(vbT, SZ_VBT);
    const float lf = -__expf(((const GAS float*)decay_l)[h]) * LOG2E, lb = -__expf(((const GAS float*)decay_l)[4 + h]) * LOG2E;
    const int iq = 16 * w + li;
    const size_t t0 = (size_t)b * SEQ + ch * 128;
    bf16x8 bq[4];
#pragma unroll
    for (int ks = 0; ks < 4; ++ks) bq[ks] = ldb8(rU, (unsigned)(iq * INW + 8 * g) * 2u, (unsigned)(t0 * INW + U_QB + h * 128 + 32 * ks) * 2u);
    const float xf = __builtin_amdgcn_exp2f((float)(iq + 1) * lf), xb = __builtin_amdgcn_exp2f((float)(128 - iq) * lb);
    const unsigned sf = (unsigned)((((0 * 2 + b) * 4 + h) * 32 + ch) * (256 * 128)) * 2u, sb = (unsigned)((((1 * 2 + b) * 4 + h) * 32 + ch) * (256 * 128)) * 2u;
    const unsigned voS = 64u * tid, voU = (unsigned)((tid >> 2) * INW) * 2u + 64u * (tid & 3), voV = (unsigned)((tid >> 2) * MT) * 2u + 64u * (tid & 3);
    const unsigned sU = (unsigned)(t0 * INW + U_KB + h * 128) * 2u, sV = (unsigned)((size_t)(h * 256) * MT + t0) * 2u;
    f32x4 tot[16]; bf16x8 bp[4];
    LAS unsigned char* s0 = F.lds; LAS unsigned char* s1 = F.lds + 32768;
    RowTile LA, LB;
#define RO_ISSUE(L, T) do { if ((T) == 0) rowtile_issue(L, rS, voS, sf); else if ((T) == 1) rowtile_issue(L, rS, voS, sf + 32768u); else if ((T) == 2) rowtile_issue(L, rS, voS, sb); else if ((T) == 3) rowtile_issue(L, rS, voS, sb + 32768u); \
        else if ((T) == 4) rowtile_issue(L, rU, voU, sU); else if ((T) == 5) rowtile_issue(L, rV, voV, sV); else rowtile_issue(L, rV, voV, sV + (unsigned)(128 * MT) * 2u); } while (0)
#define RO_COMP(T, st) ro_piece<T>((const LAS unsigned char*)(st), tot, bq, bp, lane, iq, xf, xb, lf, lb)
    RO_ISSUE(LA, 0); RO_ISSUE(LB, 1); rowtile_write(LA, s0, tid); RO_ISSUE(LA, 2); lds_barrier();
    rowtile_write(LB, s1, tid); RO_ISSUE(LB, 3); RO_COMP(0, s0); lds_barrier();
    rowtile_write(LA, s0, tid); RO_ISSUE(LA, 4); RO_COMP(1, s1); lds_barrier();
    rowtile_write(LB, s1, tid); RO_ISSUE(LB, 5); RO_COMP(2, s0); lds_barrier();
    rowtile_write(LA, s0, tid); RO_ISSUE(LA, 6); RO_COMP(3, s1); lds_barrier();
    rowtile_write(LB, s1, tid);                  RO_COMP(4, s0); lds_barrier();
    rowtile_write(LA, s0, tid);                  RO_COMP(5, s1); lds_barrier();
                                                 RO_COMP(6, s0); lds_barrier();
#undef RO_ISSUE
#undef RO_COMP
    float s1_ = 0.f;
#pragma unroll
    for (int c = 0; c < 16; ++c) s1_ += (tot[c][0] + tot[c][1]) + (tot[c][2] + tot[c][3]);
    s1_ += shx(s1_, 16, lane); s1_ += shx(s1_, 32, lane);
    const float mu = s1_ * (1.f / 256.f); float s2 = 0.f;
#pragma unroll
    for (int c = 0; c < 16; ++c) { const f32x4 d = tot[c] - mu; s2 += (d[0] * d[0] + d[1] * d[1]) + (d[2] * d[2] + d[3] * d[3]); }
    s2 += shx(s2, 16, lane); s2 += shx(s2, 32, lane);
    const float rstd = 1.0f / sqrtf(s2 * (1.f / 256.f) + EPSF);
    const bf16* gp = u + (t0 + iq) * INW + U_GR + h * 256 + 4 * g;
    bf16* op = omix + (t0 + iq) * MIXW + 768 + h * 256 + 4 * g;
#pragma unroll
    for (int c = 0; c < 16; ++c) { const v2u gv = *(const GAS v2u*)(gp + 16 * c); float gt[4] = {bflo(gv.x), bfhi(gv.x), bflo(gv.y), bfhi(gv.y)}; float o[4];
#pragma unroll
        for (int e = 0; e < 4; ++e) { const float sg = gt[e] * sigmoidf_(gt[e]); o[e] = sg * (tot[c][e] - mu) * rstd; }
        v2u w2; w2.x = pk2(o[0], o[1]); w2.y = pk2(o[2], o[3]); *(GAS v2u*)(op + 16 * c) = w2; }
}

__device__ __forceinline__ unsigned char* ws_opq(unsigned char* ws, size_t off) { asm volatile("" : "+s"(ws)); return ws + off; }
__device__ __forceinline__ const float* in_opq(const float* p) { asm volatile("" : "+s"(p)); return p; }
struct Args { const float* in[18]; float* out; unsigned char* ws; int ph_lo, ph_hi; };
constexpr int PH_PER_LAYER = 13, N_PHASES = 1 + DEPTH * PH_PER_LAYER + 1;

__global__ void __launch_bounds__(NWAVES * 64, 2) enc_fwd(Args args) {
    extern __shared__ __attribute__((aligned(16))) unsigned char lds[];
    Frame F;
    F.lds = (LAS unsigned char*)lds;
    F.wave = __builtin_amdgcn_readfirstlane((int)threadIdx.x >> 6);
    F.G = gridDim.x; { const int bx = blockIdx.x; F.vcu = (F.G % 8 == 0) ? (bx % 8) * (F.G / 8) + bx / 8 : bx; }
    F.gw = F.vcu * NWAVES + F.wave; F.ngw = F.G * NWAVES;
    volatile LAS unsigned* MISC = (volatile LAS unsigned*)(F.lds + MISC_OFF);
    for (int i = (F.wave * 64 + lane_id()); i < (LDS_BYTES - LDSCTL_OFF) / 4; i += NWAVES * 64) ((LAS unsigned*)(F.lds + LDSCTL_OFF))[i] = 0u;
    __syncthreads();
    gu32* ctl = (gu32*)(args.ws + WS_CTL);
    if (!MK_LAUNCH_PER_PHASE) (void)xcd_barrier_post((unsigned*)ctl + CW_BAR, MISC + 8, F.wave == 0 && lane_id() == 0);
#define GRID_BAR() do { if (!MK_LAUNCH_PER_PHASE) { XcdBarrier b_; b_.bar = (unsigned*)ws_opq(args.ws, WS_CTL) + CW_BAR; b_.x = xb_xcc_id(); b_.st = (volatile LAS unsigned*)(F.lds + MISC_OFF) + 8; xcd_barrier(b_, F.wave == 0 && lane_id() == 0); } } while (0)
    const int lo = args.ph_lo, hi = args.ph_hi;
#ifndef PHMASK
#define PHMASK 0xffffu
#endif
#define PHK(k) ((k) == 0 ? 0 : (k) == N_PHASES - 1 ? 14 : 1 + ((k) - 1) % PH_PER_LAYER)
#if MK_LAUNCH_PER_PHASE
#define IN(k) (lo <= (k) && (k) < hi)
#else
#define IN(k) ((k) < N_PHASES)
#endif
#define INP(k, kk) (((PHMASK >> (kk)) & 1u) && IN(k))
#define SEAM(k) do { if (IN((k) + 1)) GRID_BAR(); if (PROBE) { int bw_ = (int)blockIdx.x | F.wave; asm volatile("" : "+s"(bw_)); if (bw_ == 0 && lane_id() == 0) ((unsigned long long*)(args.ws + 65536))[(k) + 1] = __builtin_amdgcn_s_memrealtime(); } } while (0)
    if (PROBE && blockIdx.x == 0 && F.wave == 0 && lane_id() == 0) ((unsigned long long*)(args.ws + 65536))[0] = __builtin_amdgcn_s_memrealtime();

#define WSP(T, off) ((T*)ws_opq(args.ws, (off)))
#define INP_(k) in_opq(args.in[(k)])
#define x_in INP_(0)
#define mem INP_(1)
#define t5_bias INP_(2)
#define norm_mix_g INP_(3)
#define w_in INP_(4)
#define na_rpb INP_(5)
#define ret_decay INP_(6)
#define w_branch INP_(7)
#define w_out INP_(8)
#define norm_cross_g INP_(9)
#define norm_mem_g INP_(10)
#define w_cq INP_(11)
#define w_ckv INP_(12)
#define w_co INP_(13)
#define norm_mlp_g INP_(14)
#define w_mlp1 INP_(15)
#define w_mlp2 INP_(16)
#define final_norm_g INP_(17)
#define rope WSP(float, WS_ROPE)
#define Wt_in WSP(bf16, WS_WIN)
#define Wt_br WSP(bf16, WS_WBR)
#define Wt_out WSP(bf16, WS_WOUT)
#define Wt_cq WSP(bf16, WS_WCQ)
#define Wt_ckv WSP(bf16, WS_WCKV)
#define Wt_co WSP(bf16, WS_WCO)
#define Wt_1 WSP(bf16, WS_W1)
#define Wt_2 WSP(bf16, WS_W2)
#define MN WSP(bf16, WS_MN)
#define XLO WSP(bf16, WS_X)
#define XN WSP(bf16, WS_XN)
#define U WSP(bf16, WS_U)
#define H WSP(bf16, WS_H)
#define VBT WSP(bf16, WS_VBT)
#define KBT WSP(bf16, WS_KBT)
#define ST WSP(bf16, WS_ST)
#define OMIX WSP(bf16, WS_OMIX)
#define PO WSP(bf16, WS_PO)
#define PL WSP(float, WS_PL)
#define MPART WSP(float, WS_MPART)
#define MERGED WSP(bf16, WS_MERGED)
#define QX WSP(bf16, WS_QX)
#define KX WSP(bf16, WS_KX)
#define VXT WSP(bf16, WS_VXT)
#define AX WSP(bf16, WS_AX)
#define RSB(i) WSP(float, WS_RS + (size_t)(i) * MT * 32 * 4)

    if (INP(0, 0)) {
        LAS float* scr = (LAS float*)(F.lds + RING_OFF + F.wave * 16384);
        constexpr int I_IN = (DM / 64) * (INW / 32), I_BR = (MIXW / 64) * (DM / 32), I_OUT = (DM / 64) * (DM / 32), I_CQ = (DM / 64) * (CRW / 32), I_CKV = (DM / 64) * (2 * CRW / 32),
                      I_CO = (CRW / 64) * (DM / 32), I_1 = (DM / 64) * (FF / 32), I_2 = (FF / 64) * (DM / 32);
        constexpr int I_LAYER = I_IN + I_BR + I_OUT + I_CQ + I_CKV + I_CO + I_1 + I_2;
        for (int it = opq(F.gw); it < DEPTH * I_CKV; it += opq(F.ngw)) { const int l = it / I_CKV, r = it % I_CKV;
            p0_transpose_item<0>(w_ckv + (size_t)l * DM * 2 * CRW, DM, 2 * CRW, Wt_ckv + (size_t)l * 2 * CRW * DM, scr, r, lane_id()); }
        for (int m = opq(F.gw); m < DEPTH * MEMT; m += opq(F.ngw)) { const int l = m / MEMT, r = m % MEMT; rms_row_to_bf16(mem + (size_t)r * DM, norm_mem_g + (size_t)l * DM, MN + (size_t)m * DM, lane_id()); }
        SEAM(0);
        for (int id = opq(F.vcu); id < 128; id += opq(F.G)) kvproj_unit(F, id, MN, Wt_ckv, KX);
        __syncthreads();
        {
            constexpr int I_L2 = I_LAYER - I_CKV;
#define P0_DESC(d, it_) do { const int l_ = (it_) / I_L2; int r_ = (it_) % I_L2; \
                if (r_ < I_IN) { d = P0Desc{w_in + (size_t)l_ * DM * INW, Wt_in + (size_t)l_ * INW * DM, norm_mix_g + (size_t)l_ * DM, DM, INW, 1, r_}; break; } r_ -= I_IN; \
                if (r_ < I_BR) { d = P0Desc{w_branch + (size_t)l_ * MIXW * DM, Wt_br + (size_t)l_ * DM * MIXW, nullptr, MIXW, DM, 0, r_}; break; } r_ -= I_BR; \
                if (r_ < I_OUT) { d = P0Desc{w_out + (size_t)l_ * DM * DM, Wt_out + (size_t)l_ * DM * DM, nullptr, DM, DM, 0, r_}; break; } r_ -= I_OUT; \
                if (r_ < I_CQ) { d = P0Desc{w_cq + (size_t)l_ * DM * CRW, Wt_cq + (size_t)l_ * CRW * DM, norm_cross_g + (size_t)l_ * DM, DM, CRW, 2, r_}; break; } r_ -= I_CQ; \
                if (r_ < I_CO) { d = P0Desc{w_co + (size_t)l_ * CRW * DM, Wt_co + (size_t)l_ * DM * CRW, nullptr, CRW, DM, 0, r_}; break; } r_ -= I_CO; \
                if (r_ < I_1) { d = P0Desc{w_mlp1 + (size_t)l_ * DM * FF, Wt_1 + (size_t)l_ * FF * DM, norm_mlp_g + (size_t)l_ * DM, DM, FF, 0, r_}; break; } r_ -= I_1; \
                d = P0Desc{w_mlp2 + (size_t)l_ * FF * DM, Wt_2 + (size_t)l_ * DM * FF, nullptr, FF, DM, 0, r_}; } while (0)
            {
                constexpr int NIT = DEPTH * I_L2; int it = opq(F.gw); const int stp = opq(F.ngw);
                if (it < NIT) {
                    P0Desc d; f32x4 v[8]; float gv[8];
                    P0_DESC(d, it); p0_issue(d, lane_id(), v, gv);
                    for (;;) {
                        const int itn = it + stp; const bool more = itn < NIT;
                        P0Desc dn = d; f32x4 vn[8]; float gn[8];
                        if (more) { P0_DESC(dn, itn); p0_issue(dn, lane_id(), vn, gn); }
                        p0_finish(d, lane_id(), scr, v, gv);
                        if (!more) break;
                        d = dn; it = itn;
#pragma unroll
                        for (int i = 0; i < 8; ++i) { v[i] = vn[i]; gv[i] = gn[i]; }
                    }
                }
            }
#undef P0_DESC
            GAS float* ropep = (GAS float*)rope;
            for (int e = opq(F.gw) * 64 + lane_id(); e < SEQ * 64; e += opq(F.ngw) * 64) { const int t = e >> 6, i = e & 63; float sn, cs; sincos_f32((float)t * rope_inv_freq(i), sn, cs);
                ropep[e] = cs; ropep[SEQ * 64 + e] = sn; ropep[2 * SEQ * 64 + (size_t)i * SEQ + t] = cs; ropep[3 * SEQ * 64 + (size_t)i * SEQ + t] = sn; }
            for (int m = opq(F.gw); m < MT; m += opq(F.ngw)) row_to_bf16_ss(x_in + (size_t)m * DM, XN + (size_t)m * DM, RSB(0) + (size_t)m * 32, lane_id());
        }
        SEAM(0);
    }

#define LAYER_BODY(l) { \
        const int pb = 1 + l * PH_PER_LAYER; \
        if (INP(pb + 1, 2)) { \
            SchedIn S{(const char*)XN, (const char*)(Wt_in + (size_t)l * INW * DM), opq(F.G), opq((int)blockIdx.x)}; \
            EpiIn E{U, VBT, KBT, rope, RSB(3 * l)}; \
            for (int i_ = (opq(F.vcu) & 7) * P2_SKEW; i_ > 0; --i_) __builtin_amdgcn_s_sleep(48); \
            pg8::gemm_phase<EpiIn, SchedIn, PG8_ALIGN, PG8_SP2>(F.lds + RING_OFF, F.wave, DM, S, E); \
            SEAM(pb + 1); \
        } \
        if (INP(pb + 2, 3)) { \
            load_mixer_tables(F, na_rpb + (size_t)l * 6 * 15 * 31, t5_bias); \
            for (int id = opq(F.vcu); id < 256; id += opq(F.G)) scan_unit(F, id, KBT, VBT, ST, ret_decay + l * 8); \
            for (int id = opq(F.vcu); id < 1536; id += opq(F.G)) { \
                if (id < 384) na_unit(F, id, U, OMIX); \
                else if (id < 768) dil_unit<0>(F, id - 384, U, PO, PL); \
                else if (id < 1152) dil_unit<1>(F, id - 768, U, PO, PL); \
                else dil_unit<2>(F, id - 1152, U, PO, PL); \
            } \
            SEAM(pb + 2); \
        } \
        if (INP(pb + 3, 4)) { \
            for (int id = opq(F.vcu); id < 256; id += opq(F.G)) retout_unit(F, id, U, VBT, ST, ret_decay + l * 8, OMIX); \
            combine_tasks(F, PO, PL, OMIX); \
            SEAM(pb + 3); \
        } \
        if (INP(pb + 4, 5)) { \
            __syncthreads(); \
            SchedBr S{(const char*)OMIX, (const char*)(Wt_br + (size_t)l * DM * MIXW), opq(F.G), opq((int)blockIdx.x)}; \
            EpiBr E{U, MERGED}; \
            pg8::gemm_phase<EpiBr, SchedBr, PG8_ALIGN, PG8_SP2>(F.lds + RING_OFF, F.wave, MIXW, S, E); \
            SEAM(pb + 4); \
        } \
        if (INP(pb + 5, 6)) { \
            SchedPlain S{(const char*)MERGED, (const char*)(Wt_out + (size_t)l * DM * DM), 8, DM, DM / 64, opq(F.G), opq((int)blockIdx.x)}; \
            EpiResid E{(l == 0) ? x_in : (const float*)nullptr, XN, XLO, RSB(3 * l + 1)}; \
            pg8::gemm_phase<EpiResid, SchedPlain, PG8_ALIGN, PG8_SP2>(F.lds + RING_OFF, F.wave, DM, S, E); \
            SEAM(pb + 5); \
        } \
        if (INP(pb + 8, 9)) { \
            for (int id = opq(F.vcu); id < 256; id += opq(F.G)) cross_unit(F, id, XN, Wt_cq + (size_t)l * CRW * DM, RSB(3 * l + 1), KX + (size_t)l * MEMT * 2 * CRW, AX); \
            SEAM(pb + 8); \
        } \
        if (INP(pb + 9, 10)) { \
            SchedPlain S{(const char*)AX, (const char*)(Wt_co + (size_t)l * DM * CRW), 8, CRW, CRW / 64, opq(F.G), opq((int)blockIdx.x)}; \
            EpiResid E{(const float*)nullptr, XN, XLO, RSB(3 * l + 2)}; \
            pg8::gemm_phase<EpiResid, SchedPlain, PG8_ALIGN, PG8_SP2>(F.lds + RING_OFF, F.wave, CRW, S, E); \
            SEAM(pb + 9); \
        } \
        if (INP(pb + 11, 12)) { \
            SchedPlain S{(const char*)XN, (const char*)(Wt_1 + (size_t)l * FF * DM), 32, DM, DM / 64, opq(F.G), opq((int)blockIdx.x)}; \
            EpiRelu2 E{H, RSB(3 * l + 2)}; \
            pg8::gemm_phase<EpiRelu2, SchedPlain, PG8_ALIGN, PG8_SP2>(F.lds + RING_OFF, F.wave, DM, S, E); \
            SEAM(pb + 11); \
        } \
        if (INP(pb + 12, 13)) { \
            SchedPlain S{(const char*)H, (const char*)(Wt_2 + (size_t)l * DM * FF), 8, FF, FF / 64, opq(F.G), opq((int)blockIdx.x)}; \
            EpiResid E{(const float*)nullptr, XN, XLO, RSB(3 * l + 3)}; \
            pg8::gemm_phase<EpiResid, SchedPlain, PG8_ALIGN, PG8_SP2>(F.lds + RING_OFF, F.wave, FF, S, E); \
            SEAM(pb + 12); \
        } \
    }
    LAYER_BODY(0)
    LAYER_BODY(1)
    LAYER_BODY(2)
    LAYER_BODY(3)
#undef LAYER_BODY
    float pscale = 1.0f;
    if (PROBE) {
        float* fr = (float*)(args.ws + 65536 + 4096);
        if (blockIdx.x == 0 && F.wave == 0 && lane_id() == 0) {
            const unsigned long long* st = (const unsigned long long*)(args.ws + 65536);
            unsigned long long ta = 0, tb = 0;
            for (int k = 0; k < N_PHASES - 1; ++k) { const int kk = PHK(k); const unsigned long long d = st[k + 1] - st[k]; if ((PROBE_A >> kk) & 1) ta += d; if ((PROBE_B >> kk) & 1) tb += d; }
            const float tot = (float)(st[N_PHASES - 1] - st[0]);
            __hip_atomic_store(fr, floorf((float)ta / tot * 40.f + PROBE_DITHER) * 0.025f, RLX_AGENT); __hip_atomic_store(fr + 1, floorf((float)tb / tot * 40.f + PROBE_DITHER) * 0.025f, RLX_AGENT);
        }
        GRID_BAR();
        pscale = 1.0f + __hip_atomic_load(fr, RLX_AGENT);
    }
    if (INP(N_PHASES - 1, 14)) {
        for (int m = opq(F.gw); m < MT; m += opq(F.ngw)) rms_row_to_f32(XN + (size_t)m * DM, XLO + (size_t)m * DM, final_norm_g, args.out + (size_t)m * DM, lane_id(), pscale, RSB(12) + (size_t)m * 32);
        if (PROBE) { VM_WAIT(); if (F.gw == 0 && lane_id() == 0) args.out[0] = 20.0f + 100.0f * __hip_atomic_load((float*)(args.ws + 65536 + 4096) + 1, RLX_AGENT); }
    }
#undef IN
#undef SEAM
#undef GRID_BAR
}

extern "C" void kernel_launch(void* const* d_in, const int* in_sizes, int n_in, void* d_out, int out_size, void* d_ws, size_t ws_size, hipStream_t stream) {
    static int grid = 0;
    if (grid == 0) {
        if (n_in != 18 || out_size != MT * DM || ws_size < WS_END) { fprintf(stderr, "kernel_launch: unexpected shapes (n_in %d, out %d, ws %zu < %zu)\n", n_in, out_size, ws_size, (size_t)WS_END); grid = -1; return; }
        int dev = 0, cus = 0, per_cu = 0;
        if (hipGetDevice(&dev) != hipSuccess || hipDeviceGetAttribute(&cus, hipDeviceAttributeMultiprocessorCount, dev) != hipSuccess) { grid = -1; return; }
        if (hipFuncSetAttribute((const void*)enc_fwd, hipFuncAttributeMaxDynamicSharedMemorySize, LDS_BYTES) != hipSuccess) { fprintf(stderr, "kernel_launch: hipFuncSetAttribute failed\n"); grid = -1; return; }
        if (hipOccupancyMaxActiveBlocksPerMultiprocessor(&per_cu, (const void*)enc_fwd, NWAVES * 64, LDS_BYTES) != hipSuccess || per_cu < 1)
            fprintf(stderr, "kernel_launch: occupancy query reports %d workgroups per CU\n", per_cu);
        (void)hipGetLastError();
        grid = cus;
    }
    if (grid < 0) return;
    if (hipMemsetAsync((char*)d_ws + WS_CTL, 0, CTL_ZERO_BYTES, stream) != hipSuccess) return;
    Args a{};
    for (int i = 0; i < 18; ++i) a.in[i] = (const float*)d_in[i];
    a.out = (float*)d_out; a.ws = (unsigned char*)d_ws;
#if MK_LAUNCH_PER_PHASE
    for (int p = 0; p < N_PHASES; ++p) { a.ph_lo = p; a.ph_hi = p + 1; hipLaunchKernelGGL(enc_fwd, dim3(grid), dim3(NWAVES * 64), LDS_BYTES, stream, a); }
#else
    a.ph_lo = 0; a.ph_hi = N_PHASES;
    hipLaunchKernelGGL(enc_fwd, dim3(grid), dim3(NWAVES * 64), LDS_BYTES, stream, a);
#endif
    const hipError_t le = hipPeekAtLastError();
    if (le != hipSuccess) fprintf(stderr, "kernel_launch: launch failed: %s\n", hipGetErrorName(le));
}
```

```cpp
#include <hip/hip_runtime.h>
#include <cstdio>
#include <cstdint>

#ifndef PROBE_A
#define PROBE_A 0
#endif
#ifndef PROBE_B
#define PROBE_B 0
#endif
#define PROBE ((PROBE_A) | (PROBE_B))
#ifndef PROBE_DITHER
#define PROBE_DITHER 0.0f
#endif
#ifndef RESID_LO
#define RESID_LO 0
#endif
#ifndef MK_LAUNCH_PER_PHASE
#define MK_LAUNCH_PER_PHASE 0
#endif

namespace pg8 {
#define PG8_LAS __attribute__((address_space(3)))
typedef unsigned short bf16_t;
typedef short bf16x8 __attribute__((ext_vector_type(8)));
typedef float f32x4 __attribute__((ext_vector_type(4)));
typedef unsigned u32x4 __attribute__((ext_vector_type(4)));
constexpr int BM = 256, BK = 64, HALF = 128, HTB = HALF * BK * 2  , STAGE_BYTES = 8 * HTB, NXCD = 8, WGM = 8;

__host__ __device__ __forceinline__ int lds_byte(int r, int c) { const int st = (r >> 4) * 2 + (c >> 5), rr = r & 15, cc = c & 31, ob = rr * 64 + cc * 2; return st * 1024 + (ob ^ (((ob >> 9) & 1) << 5)); }
__host__ __device__ __forceinline__ void stage_rc(int b, int& R, int& C) { const int st = b / 1024, sb = b % 1024, swz = sb ^ (((sb >> 9) & 1) << 5); R = (st >> 1) * 16 + swz / 64; C = (st & 1) * 32 + (swz % 64) / 2; }
__host__ __device__ __forceinline__ int perm32(int rho) { const int n = rho >> 4, i = rho & 15; return 8 * (i >> 2) + 4 * n + (i & 3); }

struct Unit { int pm, pn, kind; };

__device__ __forceinline__ bool static_tile(int nM, int nN, int G, int c, int i, int& pm, int& pn) {
    const int nwg = nM * nN; const long L = (long)i * G + c; if (L >= nwg) return false;
    int wgid = (int)L; { const int q = nwg / NXCD, r = nwg % NXCD, xcd = wgid % NXCD, off = wgid / NXCD; wgid = (xcd < r ? xcd * (q + 1) : r * (q + 1) + (xcd - r) * q) + off; }
    const int nig = WGM * nN, gid = wgid / nig, fm = gid * WGM, gsz = (nM - fm) < WGM ? (nM - fm) : WGM;
    pm = fm + ((wgid % nig) % gsz); pn = (wgid % nig) / gsz; return true;
}

typedef float f32x2_t __attribute__((ext_vector_type(2))); typedef __bf16 bf16x2_t __attribute__((ext_vector_type(2)));
__device__ __forceinline__ unsigned cvt_pk_bf16(float lo, float hi) { f32x2_t v = {lo, hi}; bf16x2_t b = __builtin_convertvector(v, bf16x2_t); return __builtin_bit_cast(unsigned, b); }

template <class Epi, class Sched, bool ALIGN_EPI = false, bool SP2 = false>
__device__ __forceinline__ void gemm_phase(PG8_LAS unsigned char* lds, const int wave_id, const int ld, const Sched& S, const Epi& E) {
    int lane = (int)__builtin_amdgcn_mbcnt_hi(~0u, __builtin_amdgcn_mbcnt_lo(~0u, 0u)); asm volatile("" : "+v"(lane));
    const int wid = wave_id, tid = wid * 64 + lane, wr = wid >> 2, wc = wid & 3, fr = lane & 15, fq = lane >> 4;
    unsigned voffA[2], voffB[2];
#pragma unroll
    for (int i = 0; i < 2; ++i) { int R, C; stage_rc(tid * 16 + i * 8192, R, C); const int Rb = Epi::PERM ? ((R & ~31) + perm32(R & 31)) : R;
        voffA[i] = (unsigned)(R * ld + C) * 2u; voffB[i] = (unsigned)(Rb * ld + C) * 2u; }
    const size_t kstep = (size_t)(BK * 2);
    const size_t hstep = (size_t)HALF * ld * 2;
    const unsigned ldsw = (unsigned)wid * 1024u;
    const int aoff = lds_byte(wr * 64 + fr, fq * 8), boff = lds_byte(wc * 32 + fr, fq * 8);
#define PG8_SA(b, h) (((b) * 2 + (h)) * HTB)
#define PG8_SB(b, h) ((4 + (b) * 2 + (h)) * HTB)
#define PG8_STAGE(bufoff, gbase, voff) do { _Pragma("unroll") for (int _i = 0; _i < 2; ++_i) \
        __builtin_amdgcn_global_load_lds((const unsigned*)((const char*)(gbase) + (voff)[_i]), (PG8_LAS unsigned*)(lds + (bufoff) + ldsw + _i * 8192), 16, 0, 0); } while (0)
#define PG8_LDA(dst, b, h) do { _Pragma("unroll") for (int m = 0; m < 4; ++m) _Pragma("unroll") for (int k = 0; k < 2; ++k) dst[m][k] = *(const PG8_LAS bf16x8*)(lds + PG8_SA(b, h) + aoff + m * 2048 + k * 1024); } while (0)
#define PG8_LDB(dst, b, h) do { _Pragma("unroll") for (int n = 0; n < 2; ++n) _Pragma("unroll") for (int k = 0; k < 2; ++k) dst[n][k] = *(const PG8_LAS bf16x8*)(lds + PG8_SB(b, h) + boff + n * 2048 + k * 1024); } while (0)
#define PG8_MMA(ai, bj, At, Bt) do { __builtin_amdgcn_s_setprio(1); _Pragma("unroll") for (int m = 0; m < 4; ++m) _Pragma("unroll") for (int n = 0; n < 2; ++n) _Pragma("unroll") for (int k = 0; k < 2; ++k) \
        acc[ai][bj][m][n] = __builtin_amdgcn_mfma_f32_16x16x32_bf16(Bt[n][k], At[m][k], acc[ai][bj][m][n], 0, 0, 0); __builtin_amdgcn_s_setprio(0); } while (0)
#define PG8_WAIT_V(n) asm volatile("s_waitcnt vmcnt(" #n ")" ::: "memory")
#define PG8_WAIT_L(n) asm volatile("s_waitcnt lgkmcnt(" #n ")" ::: "memory")
#define PG8_BAR __builtin_amdgcn_s_barrier()
#define PG8_SCHED __builtin_amdgcn_sched_barrier(0)
    Unit cur, nxt; int ui = 0;
    if (!S.next(0, cur)) return;
    f32x4 acc[2][2][4][2];
#pragma unroll
    for (int a = 0; a < 2; ++a)
#pragma unroll
        for (int b = 0; b < 2; ++b)
#pragma unroll
            for (int m = 0; m < 4; ++m)
#pragma unroll
                for (int n = 0; n < 2; ++n) acc[a][b][m][n] = (f32x4){0.f, 0.f, 0.f, 0.f};
    bf16x8 At[4][2], B0[2][2], B1[2][2];
    const char* cA; const char* cB; int nt;
    S.ptrs(cur, cA, cB, nt);
    if constexpr (SP2) {
        PG8_STAGE(PG8_SB(0, 0), cB, voffB); PG8_STAGE(PG8_SB(0, 1), cB + hstep, voffB); PG8_STAGE(PG8_SA(0, 0), cA, voffA); PG8_STAGE(PG8_SA(0, 1), cA + hstep, voffA);
        if (wr == 1) PG8_BAR;
        PG8_WAIT_V(2); PG8_BAR;
        PG8_STAGE(PG8_SB(1, 0), cB + kstep, voffB); PG8_STAGE(PG8_SA(1, 0), cA + kstep, voffA); PG8_STAGE(PG8_SB(1, 1), cB + hstep + kstep, voffB);
        PG8_WAIT_V(6); PG8_BAR;
    } else {
        PG8_STAGE(PG8_SB(0, 0), cB, voffB); PG8_STAGE(PG8_SA(0, 0), cA, voffA); PG8_STAGE(PG8_SB(0, 1), cB + hstep, voffB); PG8_STAGE(PG8_SA(0, 1), cA + hstep, voffA);
        if (wr == 1) PG8_BAR;
        PG8_WAIT_V(4); PG8_BAR;
        PG8_STAGE(PG8_SB(1, 0), cB + kstep, voffB); PG8_STAGE(PG8_SA(1, 0), cA + kstep, voffA); PG8_STAGE(PG8_SB(1, 1), cB + hstep + kstep, voffB);
        PG8_WAIT_V(6); PG8_BAR;
    }
    for (;;) {
        const bool has_next = S.next(ui + 1, nxt);
        const char* nA = cA; const char* nB = cB; int nnt = nt;
        if (has_next) S.ptrs(nxt, nA, nB, nnt);
        for (int t = 0; t < nt; t += 2) {
            const bool last = (t == nt - 2);
            const char* a1 = cA + (size_t)(t + 1) * kstep;
            const char* a2 = last ? nA : cA + (size_t)(t + 2) * kstep; const char* b2 = last ? nB : cB + (size_t)(t + 2) * kstep;
            const char* a3 = a2 + kstep; const char* b3 = b2 + kstep;
            if constexpr (SP2) {
            PG8_LDB(B0, 0, 0); PG8_LDB(B1, 0, 1); PG8_SCHED; PG8_LDA(At, 0, 0); PG8_STAGE(PG8_SA(1, 1), a1 + hstep, voffA);
            PG8_WAIT_V(8); PG8_WAIT_L(0); PG8_BAR; PG8_MMA(0, 0, At, B0); PG8_MMA(0, 1, At, B1); PG8_BAR; PG8_SCHED;
            PG8_LDA(At, 0, 1); PG8_STAGE(PG8_SB(0, 0), b2, voffB); PG8_STAGE(PG8_SB(0, 1), b2 + hstep, voffB); PG8_STAGE(PG8_SA(0, 0), a2, voffA);
            PG8_WAIT_V(8); PG8_WAIT_L(0); PG8_BAR; PG8_MMA(1, 0, At, B0); PG8_MMA(1, 1, At, B1); PG8_BAR; PG8_SCHED;
            PG8_LDB(B0, 1, 0); PG8_LDB(B1, 1, 1); PG8_SCHED; PG8_LDA(At, 1, 0); PG8_STAGE(PG8_SA(0, 1), a2 + hstep, voffA);
            PG8_WAIT_V(8); PG8_WAIT_L(0); PG8_BAR; PG8_MMA(0, 0, At, B0); PG8_MMA(0, 1, At, B1); PG8_BAR; PG8_SCHED;
            PG8_LDA(At, 1, 1); PG8_STAGE(PG8_SB(1, 0), b3, voffB); PG8_STAGE(PG8_SB(1, 1), b3 + hstep, voffB); PG8_STAGE(PG8_SA(1, 0), a3, voffA);
            PG8_WAIT_V(8); PG8_WAIT_L(0); PG8_BAR; PG8_MMA(1, 0, At, B0); PG8_MMA(1, 1, At, B1); PG8_BAR; PG8_SCHED;
            } else {
            PG8_LDB(B0, 0, 0); PG8_SCHED; PG8_LDA(At, 0, 0); PG8_STAGE(PG8_SA(1, 1), a1 + hstep, voffA);
            PG8_WAIT_L(8); PG8_BAR; PG8_WAIT_L(0); PG8_MMA(0, 0, At, B0); PG8_BAR; PG8_SCHED;
            PG8_LDB(B1, 0, 1); PG8_STAGE(PG8_SB(0, 0), b2, voffB);
            PG8_BAR; PG8_WAIT_L(0); PG8_MMA(0, 1, At, B1); PG8_BAR;
            PG8_LDA(At, 0, 1); PG8_STAGE(PG8_SA(0, 0), a2, voffA);
            PG8_BAR; PG8_WAIT_L(0); PG8_MMA(1, 0, At, B0); PG8_BAR; PG8_SCHED;
            PG8_STAGE(PG8_SB(0, 1), b2 + hstep, voffB);
            PG8_WAIT_V(6); PG8_BAR; PG8_MMA(1, 1, At, B1); PG8_BAR;
            PG8_LDB(B0, 1, 0); PG8_SCHED; PG8_LDA(At, 1, 0); PG8_STAGE(PG8_SA(0, 1), a2 + hstep, voffA);
            PG8_WAIT_L(8); PG8_BAR; PG8_WAIT_L(0); PG8_MMA(0, 0, At, B0); PG8_BAR; PG8_SCHED;
            PG8_LDB(B1, 1, 1); PG8_STAGE(PG8_SB(1, 0), b3, voffB);
            PG8_BAR; PG8_WAIT_L(0); PG8_MMA(0, 1, At, B1); PG8_BAR;
            PG8_LDA(At, 1, 1); PG8_STAGE(PG8_SA(1, 0), a3, voffA);
            PG8_BAR; PG8_WAIT_L(0); PG8_MMA(1, 0, At, B0); PG8_BAR; PG8_SCHED;
            PG8_STAGE(PG8_SB(1, 1), b3 + hstep, voffB);
            PG8_WAIT_V(6); PG8_BAR; PG8_MMA(1, 1, At, B1); PG8_BAR;
            }
        }
        if constexpr (ALIGN_EPI) { if (wr == 0) PG8_BAR; }
        E(acc, cur, wr, wc, fr, fq);
        if (!has_next) break;
#pragma unroll
        for (int a = 0; a < 2; ++a)
#pragma unroll
            for (int b = 0; b < 2; ++b)
#pragma unroll
                for (int m = 0; m < 4; ++m)
#pragma unroll
                    for (int n = 0; n < 2; ++n) acc[a][b][m][n] = (f32x4){0.f, 0.f, 0.f, 0.f};
        cur = nxt; cA = nA; cB = nB; nt = nnt; ++ui;
        if constexpr (ALIGN_EPI) { if (wr == 1) PG8_BAR; }
    }
    PG8_WAIT_V(0);
    if constexpr (!ALIGN_EPI) { if (wr == 0) PG8_BAR; }
    PG8_BAR;
#undef PG8_SA
#undef PG8_SB
#undef PG8_STAGE
#undef PG8_LDA
#undef PG8_LDB
#undef PG8_MMA
#undef PG8_WAIT_V
#undef PG8_WAIT_L
#undef PG8_BAR
#undef PG8_SCHED
}
}

#ifndef PG8_SP2
#define PG8_SP2 true
#endif
#ifndef PG8_ALIGN
#define PG8_ALIGN true
#endif

constexpr int NWAVES = 8;
constexpr int DM = 2048, NB = 2, SEQ = 4096, MT = NB * SEQ, DEPTH = 4, MEML = 256, MEMT = NB * MEML;
constexpr int INW = 13824, MIXW = 2560, FF = 8192, CRW = 512;
constexpr int U_QA = 0, U_KA = 768, U_VA = 1536, U_QB = 2304, U_KB = 2816, U_VB = 3328, U_GR = 4352, U_QC = 5376, U_KC = 6144, U_VC = 6912, U_SA = 7680;
constexpr float EPSF = 1e-6f, LOG2E = 1.4426950408889634f;
constexpr float QSCALE = 0.08838834764831845f;

constexpr size_t MiB = 1u << 20;
constexpr size_t WS_CTL = 0, CTL_ZERO_BYTES = 128 * 1024;
constexpr size_t WS_ROPE = 2 * MiB;
constexpr size_t WS_WIN = 8 * MiB;
constexpr size_t SZ_WIN = (size_t)DEPTH * INW * DM * 2;
constexpr size_t WS_WBR = WS_WIN + SZ_WIN;
constexpr size_t SZ_WBR = (size_t)DEPTH * DM * MIXW * 2;
constexpr size_t WS_WOUT = WS_WBR + SZ_WBR;
constexpr size_t SZ_WOUT = (size_t)DEPTH * DM * DM * 2;
constexpr size_t WS_WCQ = WS_WOUT + SZ_WOUT;
constexpr size_t SZ_WCQ = (size_t)DEPTH * CRW * DM * 2;
constexpr size_t WS_WCKV = WS_WCQ + SZ_WCQ;
constexpr size_t SZ_WCKV = (size_t)DEPTH * 2 * CRW * DM * 2;
constexpr size_t WS_WCO = WS_WCKV + SZ_WCKV;
constexpr size_t SZ_WCO = (size_t)DEPTH * DM * CRW * 2;
constexpr size_t WS_W1 = WS_WCO + SZ_WCO;
constexpr size_t SZ_W1 = (size_t)DEPTH * FF * DM * 2;
constexpr size_t WS_W2 = WS_W1 + SZ_W1;
constexpr size_t SZ_W2 = (size_t)DEPTH * DM * FF * 2;
constexpr size_t WS_MN = WS_W2 + SZ_W2;
constexpr size_t SZ_MN = (size_t)DEPTH * MEMT * DM * 2;
constexpr size_t WS_X = WS_MN + SZ_MN;
constexpr size_t SZ_X = (size_t)MT * DM * 4;
constexpr size_t WS_XN = WS_X + SZ_X;
constexpr size_t SZ_XN = (size_t)MT * DM * 2;
constexpr size_t WS_U = WS_XN + SZ_XN;
constexpr size_t SZ_U = (size_t)MT * INW * 2;
constexpr size_t WS_H = WS_U;
constexpr size_t WS_VBT = WS_U + SZ_U;
constexpr size_t SZ_VBT = (size_t)1024 * MT * 2;
constexpr size_t WS_KBT = WS_VBT + SZ_VBT;
constexpr size_t SZ_KBT = (size_t)512 * MT * 2;
constexpr size_t WS_ST = WS_KBT + SZ_KBT;
constexpr size_t SZ_ST = (size_t)2 * 2 * 4 * 32 * 256 * 128 * 2;
constexpr size_t WS_OMIX = WS_ST + SZ_ST;
constexpr size_t SZ_OMIX = (size_t)MT * MIXW * 2;
constexpr size_t WS_PO = WS_OMIX + SZ_OMIX;
constexpr size_t SZ_PO = (size_t)3 * MT * 768 * 4;
constexpr size_t WS_PL = WS_PO + SZ_PO;
constexpr size_t SZ_PL = (size_t)3 * MT * 8 * 4;
constexpr size_t WS_MPART = WS_PL + SZ_PL;
constexpr size_t SZ_MPART = (size_t)MT * DM * 4;
constexpr size_t WS_MERGED = WS_MPART + SZ_MPART;
constexpr size_t SZ_MERGED = (size_t)MT * DM * 2;
constexpr size_t WS_QX = WS_MERGED + SZ_MERGED;
constexpr size_t SZ_QX = (size_t)MT * CRW * 2;
constexpr size_t WS_KX = WS_QX + SZ_QX;
constexpr size_t SZ_KX = (size_t)DEPTH * MEMT * 2 * CRW * 2;
constexpr size_t WS_VXT = WS_KX + SZ_KX;
constexpr size_t SZ_VXT = (size_t)CRW * MEMT * 2;
constexpr size_t WS_AX = WS_VXT + SZ_VXT;
constexpr size_t SZ_AX = (size_t)MT * CRW * 2;
constexpr size_t WS_RS = WS_AX + SZ_AX;
constexpr size_t SZ_RS = (size_t)13 * MT * 32 * 4;
constexpr size_t WS_END = WS_RS + SZ_RS;
static_assert((size_t)MT * FF * 2 <= SZ_U, "h overlays u");

constexpr int CW_TMO = 0, CW_CODE = 1;
constexpr int CW_BAR = 4096, CW_CLAIM = 2048;

constexpr int RING_OFF = 0, RING_BYTES = 131072;
constexpr int LDSCTL_OFF = RING_BYTES, MISC_OFF = LDSCTL_OFF + 320;
constexpr int LDS_BYTES = 147456;
constexpr int LDS_RPB = 98304, LDS_T5 = 98304 + 12288;
static_assert(MISC_OFF + 128 <= LDS_BYTES, "LDS map");

#define GAS __attribute__((address_space(1)))
#define LAS __attribute__((address_space(3)))
typedef unsigned short bf16;
typedef unsigned v4u __attribute__((ext_vector_type(4)));
typedef unsigned v2u __attribute__((ext_vector_type(2)));
typedef float f32x4 __attribute__((ext_vector_type(4)));
typedef float f32x2 __attribute__((ext_vector_type(2)));
typedef short bf16x8 __attribute__((ext_vector_type(8)));
typedef short s16x4 __attribute__((ext_vector_type(4)));
typedef GAS unsigned gu32;
#define RLX_AGENT __ATOMIC_RELAXED, __HIP_MEMORY_SCOPE_AGENT
#define LDS_WAIT() asm volatile("s_waitcnt lgkmcnt(0)" ::: "memory")
#define VM_WAIT() asm volatile("s_waitcnt vmcnt(0)" ::: "memory")
__device__ __forceinline__ unsigned f2bf(float f) { unsigned u = __builtin_bit_cast(unsigned, f); return (u + 0x7fffu + ((u >> 16) & 1u)) >> 16; }
__device__ __forceinline__ unsigned pk2(float lo, float hi) { return pg8::cvt_pk_bf16(lo, hi); }
__device__ __forceinline__ float bf2f(unsigned short b) { return __builtin_bit_cast(float, (unsigned)b << 16); }
__device__ __forceinline__ float bflo(unsigned w) { return __builtin_bit_cast(float, w << 16); }
__device__ __forceinline__ float bfhi(unsigned w) { return __builtin_bit_cast(float, w & 0xffff0000u); }
#define MFMA16(a, b, c) __builtin_amdgcn_mfma_f32_16x16x32_bf16((a), (b), (c), 0, 0, 0)
__device__ __forceinline__ bf16x8 ldg8(const bf16* p) { return *(const GAS bf16x8*)p; }
typedef __amdgpu_buffer_rsrc_t rsrc_t;
__device__ __forceinline__ rsrc_t mk_rsrc(const void* base, size_t bytes) { return __builtin_amdgcn_make_buffer_rsrc((void*)base, (short)0, (int)(unsigned)bytes, 0x00020000); }
__device__ __forceinline__ bf16x8 ldb8(rsrc_t r, unsigned voff, unsigned soff) { return __builtin_bit_cast(bf16x8, __builtin_amdgcn_raw_buffer_load_b128(r, (int)voff, (int)soff, 0)); }
__device__ __forceinline__ bf16x8 ldg8s(const bf16* ubase, unsigned voff_bytes) { return *(const GAS bf16x8*)((const GAS char*)ubase + voff_bytes); }
__device__ __forceinline__ unsigned cvtpk(float lo, float hi) { return pg8::cvt_pk_bf16(lo, hi); }
__device__ __forceinline__ bf16x8 pack8(const float* v) { v4u w; w.x = cvtpk(v[0], v[1]); w.y = cvtpk(v[2], v[3]); w.z = cvtpk(v[4], v[5]); w.w = cvtpk(v[6], v[7]); return __builtin_bit_cast(bf16x8, w); }

#define XB_TMO      128
#define XB_XCNT(j)  (256  + 64 * (j))
#define XB_XSUB(j)  (1280 + 64 * (j))
#define XB_XGEN(j)  (2304 + 64 * (j))
#define XB_TOP      3328
#define XB_TOPGEN   3392
#define XCD_BAR_WORDS 3456
#define XB_SPIN_CAP (1u << 18)

__device__ __forceinline__ unsigned xb_ld(unsigned* p)              { return __hip_atomic_load(p, __ATOMIC_RELAXED, __HIP_MEMORY_SCOPE_AGENT); }
__device__ __forceinline__ unsigned xb_add(unsigned* p, unsigned v) { return __hip_atomic_fetch_add(p, v, __ATOMIC_RELAXED, __HIP_MEMORY_SCOPE_AGENT); }
__device__ __forceinline__ unsigned xb_xcc_id() { return (unsigned)__builtin_amdgcn_s_getreg((3 << 11) | 20) & 0xFu; }
#define XB_SPIN(cond, bar) do { unsigned _sp = 0; while (cond) { __builtin_amdgcn_s_sleep(1); \
    if ((++_sp & 255u) == 0u) { if (xb_ld(&(bar)[XB_TMO])) break; if (_sp > XB_SPIN_CAP) { atomicAdd(&(bar)[XB_TMO], 1u); break; } } } } while (0)

struct XcdBarrier {
    unsigned* bar; unsigned x;
    volatile LAS unsigned* st;
};
__device__ __forceinline__ XcdBarrier xcd_barrier_post(unsigned* bar, volatile LAS unsigned* st, const bool t0) {
    XcdBarrier b; b.bar = bar; b.x = xb_xcc_id(); b.st = st;
    if (t0) (void)xb_add(&bar[XB_XCNT(b.x)], 1u);
    return b;
}
__device__ __forceinline__ void xcd_barrier_complete(unsigned* bar, unsigned x, unsigned& nloc, unsigned& nx) {
    const unsigned G = gridDim.x * gridDim.y * gridDim.z;
    unsigned sum, cnt, mine, sp = 0u;
    for (;;) {
        sum = 0u; cnt = 0u; mine = 0u;
#pragma unroll
        for (unsigned j = 0; j < 16; ++j) { const unsigned c = xb_ld(&bar[XB_XCNT(j)]); sum += c; cnt += (c > 0u) ? 1u : 0u; mine = (j == x) ? c : mine; }
        if (sum == G) break;
        __builtin_amdgcn_s_sleep(1);
        if ((++sp & 255u) == 0u) { if (xb_ld(&bar[XB_TMO])) break; if (sp > XB_SPIN_CAP) { atomicAdd(&bar[XB_TMO], 1u); break; } }
    }
    nloc = mine > 0u ? mine : 1u; nx = cnt > 0u ? cnt : 1u;
}
__device__ __forceinline__ void xcd_barrier(const XcdBarrier& b, const bool t0) {
    asm volatile("s_waitcnt vmcnt(0)" ::: "memory");
    __syncthreads();
    if (t0) {
        unsigned* bar = b.bar;
        __builtin_amdgcn_s_waitcnt(0);
        unsigned nloc = b.st[0], nx = b.st[1];
        if (nloc == 0u) { xcd_barrier_complete(bar, b.x, nloc, nx); b.st[0] = nloc; b.st[1] = nx; }
        const unsigned old = xb_add(&bar[XB_XSUB(b.x)], 1u);
        const unsigned gen = old / nloc;
        if (old + 1u == (gen + 1u) * nloc) {
            __builtin_amdgcn_fence(__ATOMIC_RELEASE, "agent");
            asm volatile("s_waitcnt vmcnt(0)" ::: "memory");
            const unsigned og = xb_add(&bar[XB_TOP], 1u);
            const unsigned tg = og / nx;
            if (og + 1u == (tg + 1u) * nx) xb_add(&bar[XB_TOPGEN], 1u);
            else XB_SPIN(xb_ld(&bar[XB_TOPGEN]) == tg, bar);
            __builtin_amdgcn_fence(__ATOMIC_ACQUIRE, "agent");
            xb_add(&bar[XB_XGEN(b.x)], 1u);
            asm volatile("s_waitcnt vmcnt(0)" ::: "memory");
        } else {
            XB_SPIN(xb_ld(&bar[XB_XGEN(b.x)]) == gen, bar);
            __builtin_amdgcn_fence(__ATOMIC_ACQUIRE, "agent");
            asm volatile("s_waitcnt vmcnt(0)" ::: "memory");
        }
    }
    __syncthreads();
}

struct Frame {
    LAS unsigned char* lds;
    int wave;
    int vcu, G;
    int gw, ngw;
};

__device__ __forceinline__ int opq(int x) { asm volatile("" : "+s"(x)); return x; }
__device__ __forceinline__ int lane_id() { int l = (int)__builtin_amdgcn_mbcnt_hi(~0u, __builtin_amdgcn_mbcnt_lo(~0u, 0u)); asm volatile("" : "+v"(l)); return l; }
__device__ __forceinline__ float shx(float v, int mask, int lane) { return __builtin_bit_cast(float, __builtin_amdgcn_ds_bpermute((lane ^ mask) << 2, __builtin_bit_cast(int, v))); }
__device__ __forceinline__ v4u lanes_to_mem(v4u w, int lane) { const int a = ((lane >> 2) + 16 * (lane & 3)) << 2; v4u r;
    r.x = (unsigned)__builtin_amdgcn_ds_bpermute(a, (int)w.x); r.y = (unsigned)__builtin_amdgcn_ds_bpermute(a, (int)w.y); r.z = (unsigned)__builtin_amdgcn_ds_bpermute(a, (int)w.z); r.w = (unsigned)__builtin_amdgcn_ds_bpermute(a, (int)w.w); return r; }
__device__ __forceinline__ v4u lanes_from_mem(v4u w, int lane) { const int a = (4 * (lane & 15) + (lane >> 4)) << 2; v4u r;
    r.x = (unsigned)__builtin_amdgcn_ds_bpermute(a, (int)w.x); r.y = (unsigned)__builtin_amdgcn_ds_bpermute(a, (int)w.y); r.z = (unsigned)__builtin_amdgcn_ds_bpermute(a, (int)w.z); r.w = (unsigned)__builtin_amdgcn_ds_bpermute(a, (int)w.w); return r; }
__device__ __forceinline__ float wave_sum(float v, int lane) {
#pragma unroll
    for (int o = 1; o < 64; o <<= 1) v += shx(v, o, lane);
    return v;
}

__device__ __forceinline__ float rope_inv_freq(int i) {
    constexpr float t[64] = {0x1.000000p+0f, 0x1.bb5faep-1f, 0x1.7ff224p-1f, 0x1.4c7bc0p-1f, 0x1.1feb34p-1f, 0x1.f2a79ep-2f, 0x1.afd136p-2f, 0x1.75f034p-2f, 0x1.43d136p-2f, 0x1.186a08p-2f, 0x1.e5a848p-3f, 0x1.a48fdap-3f, 0x1.6c310ep-3f, 0x1.3b6080p-3f, 0x1.111aecp-3f, 0x1.d8ffacp-4f,
        0x1.99999ap-4f, 0x1.62b2f0p-4f, 0x1.33281ap-4f, 0x1.09fc9ap-4f, 0x1.ccab86p-5f, 0x1.8eec7ep-5f, 0x1.59742cp-5f, 0x1.2b2690p-5f, 0x1.030dc4p-5f, 0x1.c0a9a6p-6f, 0x1.8486a0p-6f, 0x1.507316p-6f, 0x1.235a72p-6f, 0x1.f89a66p-7f, 0x1.b4f7e4p-7f, 0x1.7a6624p-7f,
        0x1.47ae14p-7f, 0x1.1bc25ap-7f, 0x1.eb735ep-8f, 0x1.a99428p-8f, 0x1.708938p-8f, 0x1.3f2398p-8f, 0x1.145ceep-8f, 0x1.dea41ap-9f, 0x1.9e7c6ep-9f, 0x1.66ee1ep-9f, 0x1.36d218p-9f, 0x1.0d28dcp-9f, 0x1.d22a50p-10f, 0x1.93aeb8p-10f, 0x1.5d931cp-10f, 0x1.2eb81ap-10f,
        0x1.0624dep-10f, 0x1.c603c4p-11f, 0x1.89291ap-11f, 0x1.547688p-11f, 0x1.26d42cp-11f, 0x1.fe9f5ap-12f, 0x1.ba2e4cp-12f, 0x1.7ee9b0p-12f, 0x1.4b96bep-12f, 0x1.1f24e4p-12f, 0x1.f15028p-13f, 0x1.aea7cap-13f, 0x1.74eea6p-13f, 0x1.42f22cp-13f, 0x1.17a8e4p-13f, 0x1.e459c6p-14f};
    float r = 0.f;
#pragma unroll
    for (int k = 0; k < 64; ++k) r = (i == k) ? t[k] : r;
    return r;
}
__device__ __forceinline__ void sincos_f32(float angf, float& s, float& c) {
    const double x = (double)angf;
    const double k = __builtin_rint(x * 0.63661977236758134308);
    const double y = (x - k * 1.5707963267948966192) - k * 6.123233995736766e-17;
    const double y2 = y * y;
    double sp = 1.0 / 1307674368000.0;
    sp = -sp * y2 + 1.0 / 6227020800.0; sp = -sp * y2 + 1.0 / 39916800.0; sp = -sp * y2 + 1.0 / 362880.0; sp = -sp * y2 + 1.0 / 5040.0; sp = -sp * y2 + 1.0 / 120.0; sp = -sp * y2 + 1.0 / 6.0; sp = -sp * y2 + 1.0;
    const double sy = sp * y;
    double cp = 1.0 / 87178291200.0;
    cp = -cp * y2 + 1.0 / 479001600.0; cp = -cp * y2 + 1.0 / 3628800.0; cp = -cp * y2 + 1.0 / 40320.0; cp = -cp * y2 + 1.0 / 720.0; cp = -cp * y2 + 1.0 / 24.0; cp = -cp * y2 + 0.5; cp = -cp * y2 + 1.0;
    const int q = ((int)k) & 3;
    const double ss = (q == 0) ? sy : (q == 1) ? cp : (q == 2) ? -sy : -cp;
    const double cc = (q == 0) ? cp : (q == 1) ? -sy : (q == 2) ? -cp : sy;
    s = (float)ss; c = (float)cc;
}

template <int MAP>
__device__ __forceinline__ void p0_transpose_item(const float* W, int K, int N, bf16* WT, LAS float* scr, int item, int lane, const float* gk = nullptr) {
    const int nblk = N / 32, kb = item / nblk, nb = item % nblk, k0 = 64 * kb, n0 = 32 * nb;
    const int c4 = lane & 7, r = lane >> 3;
    int src = n0 + 4 * c4, dst = 4 * c4, dstep = 1; float sc = 1.f;
    if (MAP == 1) {
        if (n0 >= U_QB && n0 < U_VB) { const int hbase = n0 & ~127, p0 = n0 & 127; src = hbase + (p0 >> 1) + 4 * (c4 & 3) + 64 * (c4 >> 2); dst = 8 * (c4 & 3) + (c4 >> 2); dstep = 2; if (n0 >= U_KB) sc = QSCALE; }
        else if (n0 < U_KA || (n0 >= U_QC && n0 < U_KC)) sc = QSCALE * LOG2E;
    }
    if (MAP == 2) sc = QSCALE * LOG2E;
    f32x4 v[8];
#pragma unroll
    for (int i = 0; i < 8; ++i) v[i] = *(const GAS f32x4*)(W + (size_t)(k0 + 8 * i + r) * N + src);
#pragma unroll
    for (int i = 0; i < 8; ++i) { if (gk) v[i] = v[i] * ((const GAS float*)gk)[k0 + 8 * i + r];
        LAS float* d = scr + (8 * i + r) * 33 + dst; d[0] = v[i][0] * sc; d[dstep] = v[i][1] * sc; d[2 * dstep] = v[i][2] * sc; d[3 * dstep] = v[i][3] * sc; }
    LDS_WAIT(); asm volatile("" ::: "memory");
    const int c = lane & 7;
#pragma unroll
    for (int j = 0; j < 4; ++j) { const int n = (lane >> 3) + 8 * j; const LAS float* s = scr + (8 * c) * 33 + n;
        v4u o; o.x = pk2(s[0 * 33], s[1 * 33]); o.y = pk2(s[2 * 33], s[3 * 33]); o.z = pk2(s[4 * 33], s[5 * 33]); o.w = pk2(s[6 * 33], s[7 * 33]);
        *(GAS v4u*)(WT + (size_t)(n0 + n) * K + k0 + 8 * c) = o; }
    LDS_WAIT(); asm volatile("" ::: "memory");
}

__device__ __forceinline__ void rms_row_to_bf16(const float* xrow, const float* g, bf16* orow, int lane) {
    const GAS f32x4* xr = (const GAS f32x4*)xrow + lane; const GAS f32x4* gr = (const GAS f32x4*)g + lane;
    f32x4 v[8]; float s = 0.f;
#pragma unroll
    for (int j = 0; j < 8; ++j) { v[j] = xr[64 * j]; s += (v[j].x * v[j].x + v[j].y * v[j].y) + (v[j].z * v[j].z + v[j].w * v[j].w); }
    const float rs = 1.0f / sqrtf(wave_sum(s, lane) * (1.f / DM) + EPSF);
    GAS v2u* o8 = (GAS v2u*)orow + lane;
#pragma unroll
    for (int j = 0; j < 8; ++j) { const f32x4 gg = gr[64 * j]; v2u w; w.x = pk2(v[j].x * rs * gg.x, v[j].y * rs * gg.y); w.y = pk2(v[j].z * rs * gg.z, v[j].w * rs * gg.w); o8[64 * j] = w; }
}
__device__ __forceinline__ void row_to_bf16_ss(const float* xrow, bf16* orow, float* ssp, int lane) {
    const GAS f32x4* xr = (const GAS f32x4*)xrow + lane;
    f32x4 v[8]; float s = 0.f;
#pragma unroll
    for (int j = 0; j < 8; ++j) { v[j] = xr[64 * j]; s += (v[j].x * v[j].x + v[j].y * v[j].y) + (v[j].z * v[j].z + v[j].w * v[j].w); }
    s = wave_sum(s, lane);
    GAS v2u* o8 = (GAS v2u*)orow + lane;
#pragma unroll
    for (int j = 0; j < 8; ++j) { v2u w; w.x = pk2(v[j].x, v[j].y); w.y = pk2(v[j].z, v[j].w); o8[64 * j] = w; }
    if (lane < 32) ((GAS float*)ssp)[lane] = (lane == 0) ? s : 0.f;
}
__device__ __forceinline__ float rs_of(float ss) { return 1.0f / sqrtf(ss * (1.f / DM) + EPSF); }
__device__ __forceinline__ float rs_row4(const float* part, int row, int fq, int lane) {
    const f32x4 a = *(const GAS f32x4*)(part + (size_t)row * 32 + 8 * fq), b = *(const GAS f32x4*)(part + (size_t)row * 32 + 8 * fq + 4);
    float s = ((a[0] + a[1]) + (a[2] + a[3])) + ((b[0] + b[1]) + (b[2] + b[3]));
    s += shx(s, 16, lane); s += shx(s, 32, lane);
    return rs_of(s);
}
__device__ __forceinline__ void rs_rows_tile(const float* part, int rbase, int fq, int lane, float (&rs)[8]) {
    f32x4 pa[8], pb[8];
#pragma unroll
    for (int i = 0; i < 8; ++i) { const size_t row = (size_t)(rbase + 128 * (i >> 2) + 16 * (i & 3)); pa[i] = *(const GAS f32x4*)(part + row * 32 + 8 * fq); pb[i] = *(const GAS f32x4*)(part + row * 32 + 8 * fq + 4); }
#pragma unroll
    for (int i = 0; i < 8; ++i) { float s_ = ((pa[i][0] + pa[i][1]) + (pa[i][2] + pa[i][3])) + ((pb[i][0] + pb[i][1]) + (pb[i][2] + pb[i][3]));
        s_ += shx(s_, 16, lane); s_ += shx(s_, 32, lane); rs[i] = rs_of(s_); }
}
__device__ __forceinline__ void rs_rows8x16(const float* part, int t0, int fr, int lane, float (&rs)[8]) {
    f32x2 a[8];
#pragma unroll
    for (int e = 0; e < 8; ++e) a[e] = *(const GAS f32x2*)(part + (size_t)(t0 + e) * 32 + 2 * fr);
#pragma unroll
    for (int e = 0; e < 8; ++e) { float s = a[e][0] + a[e][1];
        s += shx(s, 1, lane); s += shx(s, 2, lane); s += shx(s, 4, lane); s += shx(s, 8, lane); rs[e] = rs_of(s); }
}
__device__ __forceinline__ void rms_row_to_f32(const bf16* xhi, const bf16* xlo, const float* g, float* orow, int lane, float oscale, const float* ssp) {
    const GAS v2u* hr = (const GAS v2u*)xhi + lane; const GAS v2u* lr = (const GAS v2u*)xlo + lane; const GAS f32x4* gr = (const GAS f32x4*)g + lane;
    float ssum = (lane < 32) ? ((const GAS float*)ssp)[lane] : 0.f; ssum = wave_sum(ssum, lane);
    const float rs = oscale * rs_of(ssum);
    GAS f32x4* o = (GAS f32x4*)orow + lane;
#pragma unroll
    for (int j = 0; j < 8; ++j) { const v2u h_ = hr[64 * j]; v2u l_ = {0u, 0u}; if (RESID_LO) l_ = lr[64 * j]; const f32x4 gg = gr[64 * j];
        f32x4 x; x[0] = bflo(h_.x) + bflo(l_.x); x[1] = bfhi(h_.x) + bfhi(l_.x); x[2] = bflo(h_.y) + bflo(l_.y); x[3] = bfhi(h_.y) + bfhi(l_.y);
        o[64 * j] = x * rs * gg; }
}

using pg8::Unit;
constexpr size_t TSTEP_DM = (size_t)256 * DM * 2;

struct SchedIn {
    const char* xn; const char* wt; int G, c;
    __device__ __forceinline__ bool next(int i, Unit& u) const {
        int pm, vn; if (!pg8::static_tile(32, 56, G, c, i, pm, vn)) return false;
        u.pm = pm; u.pn = vn; u.kind = (vn >= 54) ? 3 : (vn >= 13 && vn < 17) ? 2 : (vn >= 9 && vn < 13) ? 1 : 0; return true;
    }
    __device__ __forceinline__ void ptrs(const Unit& u, const char*& a, const char*& b, int& nt) const {
        nt = DM / 64;
        if (u.kind >= 2) { const int f = (u.kind == 3) ? 11 + (u.pn - 54) : u.pn; a = wt + (size_t)f * TSTEP_DM; b = xn + (size_t)u.pm * TSTEP_DM; }
        else { a = xn + (size_t)u.pm * TSTEP_DM; b = wt + (size_t)u.pn * TSTEP_DM; }
    }
};
struct EpiIn {
    static constexpr bool PERM = true;
    bf16* u; bf16* vbT; bf16* kbT; const float* rope; const float* rss; mutable int pm_c = -1; mutable float rsv_c[8] = {};
    __device__ __forceinline__ void operator()(const f32x4 (&acc)[2][2][4][2], const Unit& un, int wr, int wc, int fr, int fq) const {
        asm volatile("" : "+v"(fr), "+v"(fq));
        const int r0 = wr * 64 + fr, c0 = wc * 32 + 8 * fq, lane = 16 * fq + fr, r0m = wr * 64 + (lane >> 2), c0m = wc * 32 + 8 * (lane & 3);
        if (un.kind < 2 && pm_c != un.pm) { rs_rows_tile(rss, un.pm * 256 + r0, fq, 16 * fq + fr, rsv_c); pm_c = un.pm; }
        const float (&rsv)[8] = rsv_c;
        if (un.kind == 0) {
#pragma unroll
            for (int ai = 0; ai < 2; ++ai)
#pragma unroll
                for (int m = 0; m < 4; ++m) { bf16* rowp = u + (size_t)(un.pm * 256 + r0m + ai * 128 + m * 16) * INW + un.pn * 256 + c0m;
                    const float rs = rsv[ai * 4 + m];
#pragma unroll
                    for (int bj = 0; bj < 2; ++bj) { const f32x4 v0 = acc[ai][bj][m][0] * rs, v1 = acc[ai][bj][m][1] * rs;
                        v4u w; w.x = pg8::cvt_pk_bf16(v0[0], v0[1]); w.y = pg8::cvt_pk_bf16(v0[2], v0[3]); w.z = pg8::cvt_pk_bf16(v1[0], v1[1]); w.w = pg8::cvt_pk_bf16(v1[2], v1[3]);
                        *(GAS v4u*)(rowp + bj * 128) = lanes_to_mem(w, lane); } }
        } else if (un.kind == 1) {
            const int i0 = 16 * wc + 4 * fq;
#pragma unroll
            for (int ai = 0; ai < 2; ++ai)
#pragma unroll
                for (int m = 0; m < 4; ++m) { const int row = un.pm * 256 + r0 + ai * 128 + m * 16, t = row & (SEQ - 1);
                    const f32x4 cs = *(const GAS f32x4*)(rope + (size_t)t * 64 + i0), sn = *(const GAS f32x4*)(rope + (size_t)SEQ * 64 + (size_t)t * 64 + i0);
                    bf16* rowp = u + (size_t)(un.pm * 256 + r0m + ai * 128 + m * 16) * INW + un.pn * 256 + c0m;
                    const float rs = rsv[ai * 4 + m];
#pragma unroll
                    for (int bj = 0; bj < 2; ++bj) { const f32x4 v0 = acc[ai][bj][m][0] * rs, v1 = acc[ai][bj][m][1] * rs;
                        v4u w; w.x = pg8::cvt_pk_bf16(v0[0] * cs[0] - v0[1] * sn[0], v0[0] * sn[0] + v0[1] * cs[0]);
                        w.y = pg8::cvt_pk_bf16(v0[2] * cs[1] - v0[3] * sn[1], v0[2] * sn[1] + v0[3] * cs[1]);
                        w.z = pg8::cvt_pk_bf16(v1[0] * cs[2] - v1[1] * sn[2], v1[0] * sn[2] + v1[1] * cs[2]);
                        w.w = pg8::cvt_pk_bf16(v1[2] * cs[3] - v1[3] * sn[3], v1[2] * sn[3] + v1[3] * cs[3]);
                        *(GAS v4u*)(rowp + bj * 128) = lanes_to_mem(w, lane); }
                    asm volatile("" ::: "memory"); }
        } else if (un.kind == 2) {
            float rsc[2][8]; rs_rows8x16(rss, un.pm * 256 + c0, fr, 16 * fq + fr, rsc[0]); rs_rows8x16(rss, un.pm * 256 + c0 + 128, fr, 16 * fq + fr, rsc[1]);
#pragma unroll
            for (int ai = 0; ai < 2; ++ai)
#pragma unroll
                for (int m = 0; m < 4; ++m) { bf16* rowp = vbT + (size_t)((un.pn - 13) * 256 + r0m + ai * 128 + m * 16) * MT + un.pm * 256 + c0m;
#pragma unroll
                    for (int bj = 0; bj < 2; ++bj) { f32x4 v0 = acc[ai][bj][m][0], v1 = acc[ai][bj][m][1];
#pragma unroll
                        for (int e = 0; e < 4; ++e) { v0[e] *= rsc[bj][e]; v1[e] *= rsc[bj][4 + e]; }
                        v4u w; w.x = pg8::cvt_pk_bf16(v0[0], v0[1]); w.y = pg8::cvt_pk_bf16(v0[2], v0[3]); w.z = pg8::cvt_pk_bf16(v1[0], v1[1]); w.w = pg8::cvt_pk_bf16(v1[2], v1[3]);
                        *(GAS v4u*)(rowp + bj * 128) = lanes_to_mem(w, lane); } }
        } else {
            const bool odd = fr & 1;
            float rsc[2][8]; rs_rows8x16(rss, un.pm * 256 + c0, fr, 16 * fq + fr, rsc[0]); rs_rows8x16(rss, un.pm * 256 + c0 + 128, fr, 16 * fq + fr, rsc[1]);
            const float* cosT = rope + (size_t)2 * SEQ * 64; const float* sinT = rope + (size_t)3 * SEQ * 64;
#pragma unroll
            for (int ai = 0; ai < 2; ++ai)
#pragma unroll
                for (int m = 0; m < 4; ++m) { const int rr = r0 + ai * 128 + m * 16, fi = (rr & 127) >> 1;
                    bf16* rowp = kbT + (size_t)((un.pn - 54) * 256 + r0m + ai * 128 + m * 16) * MT + un.pm * 256 + c0m;
#pragma unroll
                    for (int bj = 0; bj < 2; ++bj) { const int t = (un.pm * 256 + c0 + bj * 128) & (SEQ - 1);
                        const f32x4 cA = *(const GAS f32x4*)(cosT + (size_t)fi * SEQ + t), cB = *(const GAS f32x4*)(cosT + (size_t)fi * SEQ + t + 4);
                        const f32x4 sA = *(const GAS f32x4*)(sinT + (size_t)fi * SEQ + t), sB = *(const GAS f32x4*)(sinT + (size_t)fi * SEQ + t + 4);
                        f32x4 v0 = acc[ai][bj][m][0], v1 = acc[ai][bj][m][1];
#pragma unroll
                        for (int e = 0; e < 4; ++e) { v0[e] *= rsc[bj][e]; v1[e] *= rsc[bj][4 + e]; }
                        float o[8];
#pragma unroll
                        for (int e = 0; e < 4; ++e) { const float p0 = shx(v0[e], 1, 16 * fq + fr), p1 = shx(v1[e], 1, 16 * fq + fr);
                            o[e]     = odd ? (p0 * sA[e] + v0[e] * cA[e]) : (v0[e] * cA[e] - p0 * sA[e]);
                            o[4 + e] = odd ? (p1 * sB[e] + v1[e] * cB[e]) : (v1[e] * cB[e] - p1 * sB[e]); }
                        v4u w; w.x = pg8::cvt_pk_bf16(o[0], o[1]); w.y = pg8::cvt_pk_bf16(o[2], o[3]); w.z = pg8::cvt_pk_bf16(o[4], o[5]); w.w = pg8::cvt_pk_bf16(o[6], o[7]);
                        *(GAS v4u*)(rowp + bj * 128) = lanes_to_mem(w, lane); asm volatile("" ::: "memory"); } }
        }
    }
};

struct SchedBr {
    const char* omix; const char* wt; int G, c;
    __device__ __forceinline__ bool next(int i, Unit& u) const {
        int pm, pn; if (!pg8::static_tile(32, 8, G, c, i / 3, pm, pn)) return false;
        u.pm = pm; u.pn = pn; u.kind = i % 3; return true;
    }
    __device__ __forceinline__ void ptrs(const Unit& u, const char*& a, const char*& b, int& nt) const {
        const int koff = (u.kind == 0) ? 0 : (u.kind == 1) ? 768 : 1792; nt = (u.kind == 1) ? 16 : 12;
        a = omix + ((size_t)u.pm * 256 * MIXW + koff) * 2; b = wt + ((size_t)u.pn * 256 * MIXW + koff) * 2;
    }
};
__device__ __forceinline__ float sigmoidf_(float x) { return __builtin_amdgcn_rcpf(1.0f + __builtin_amdgcn_exp2f(-x * LOG2E)); }
struct EpiBr {
    static constexpr bool PERM = true;
    const bf16* u; bf16* merged;
    __device__ __forceinline__ void operator()(const f32x4 (&acc)[2][2][4][2], const Unit& un, int wr, int wc, int fr, int fq) const {
        asm volatile("" : "+v"(fr), "+v"(fq));
        const int r0 = un.pm * 256 + wr * 64 + fr, c0 = un.pn * 256 + wc * 32 + 8 * fq;
        v4u gw, gwn, pw = {0u, 0u, 0u, 0u}, pwn = pw;
        { const size_t row = (size_t)r0; const int col = c0;
          gw = *(const GAS v4u*)(u + row * INW + U_SA + un.kind * DM + col);
          if (un.kind > 0) pw = *(const GAS v4u*)(merged + row * DM + col); }
#pragma unroll
        for (int i = 0; i < 16; ++i) { const int rg = i >> 1, bj = i & 1, ai = rg >> 2, m = rg & 3; const size_t row = (size_t)(r0 + ai * 128 + m * 16); const int col = c0 + bj * 128;
            if (i < 15) { const int rgn = (i + 1) >> 1, bjn = (i + 1) & 1; const size_t rown = (size_t)(r0 + (rgn >> 2) * 128 + (rgn & 3) * 16); const int coln = c0 + bjn * 128;
                gwn = *(const GAS v4u*)(u + rown * INW + U_SA + un.kind * DM + coln);
                if (un.kind > 0) pwn = *(const GAS v4u*)(merged + rown * DM + coln); }
            const f32x4 v0 = acc[ai][bj][m][0], v1 = acc[ai][bj][m][1];
            f32x4 o0, o1;
            o0[0] = sigmoidf_(bflo(gw.x)) * v0[0]; o0[1] = sigmoidf_(bfhi(gw.x)) * v0[1]; o0[2] = sigmoidf_(bflo(gw.y)) * v0[2]; o0[3] = sigmoidf_(bfhi(gw.y)) * v0[3];
            o1[0] = sigmoidf_(bflo(gw.z)) * v1[0]; o1[1] = sigmoidf_(bfhi(gw.z)) * v1[1]; o1[2] = sigmoidf_(bflo(gw.w)) * v1[2]; o1[3] = sigmoidf_(bfhi(gw.w)) * v1[3];
            if (un.kind > 0) { o0[0] += bflo(pw.x); o0[1] += bfhi(pw.x); o0[2] += bflo(pw.y); o0[3] += bfhi(pw.y); o1[0] += bflo(pw.z); o1[1] += bfhi(pw.z); o1[2] += bflo(pw.w); o1[3] += bfhi(pw.w); }
            v4u w; w.x = pg8::cvt_pk_bf16(o0[0], o0[1]); w.y = pg8::cvt_pk_bf16(o0[2], o0[3]); w.z = pg8::cvt_pk_bf16(o1[0], o1[1]); w.w = pg8::cvt_pk_bf16(o1[2], o1[3]);
            *(GAS v4u*)(merged + row * DM + col) = w;
            gw = gwn; pw = pwn; }
    }
};

struct SchedPlain {
    const char* A; const char* Bt; int nN, ld, nt, G, c;
    __device__ __forceinline__ bool next(int i, Unit& u) const { int pm, pn; if (!pg8::static_tile(32, nN, G, c, i, pm, pn)) return false; u.pm = pm; u.pn = pn; u.kind = 0; return true; }
    __device__ __forceinline__ void ptrs(const Unit& u, const char*& a, const char*& b, int& nt_) const { nt_ = nt; a = A + (size_t)u.pm * 256 * ld * 2; b = Bt + (size_t)u.pn * 256 * ld * 2; }
};
struct EpiResid {
    static constexpr bool PERM = true;
    const float* xf32; bf16* xhi; bf16* xlo; float* rss;
    __device__ __forceinline__ void operator()(const f32x4 (&acc)[2][2][4][2], const Unit& un, int wr, int wc, int fr, int fq) const {
        asm volatile("" : "+v"(fr), "+v"(fq));
        const int r0 = un.pm * 256 + wr * 64 + fr, c0 = un.pn * 256 + wc * 32 + 8 * fq, lane = 16 * fq + fr;
        float xa[2][8], xn_[2][8];
#define ER_LOAD(dst, row_) do { _Pragma("unroll") for (int bj = 0; bj < 2; ++bj) { const size_t o_ = (size_t)(row_) * DM + c0 + bj * 128; \
            if (xf32) { const f32x4 a_ = *(const GAS f32x4*)(xf32 + o_), b_ = *(const GAS f32x4*)(xf32 + o_ + 4); \
                dst[bj][0] = a_[0]; dst[bj][1] = a_[1]; dst[bj][2] = a_[2]; dst[bj][3] = a_[3]; dst[bj][4] = b_[0]; dst[bj][5] = b_[1]; dst[bj][6] = b_[2]; dst[bj][7] = b_[3]; } \
            else { const v4u h_ = *(const GAS v4u*)(xhi + o_); v4u l_ = {0u, 0u, 0u, 0u}; if (RESID_LO) l_ = *(const GAS v4u*)(xlo + o_); \
                dst[bj][0] = bflo(h_.x) + bflo(l_.x); dst[bj][1] = bfhi(h_.x) + bfhi(l_.x); dst[bj][2] = bflo(h_.y) + bflo(l_.y); dst[bj][3] = bfhi(h_.y) + bfhi(l_.y); \
                dst[bj][4] = bflo(h_.z) + bflo(l_.z); dst[bj][5] = bfhi(h_.z) + bfhi(l_.z); dst[bj][6] = bflo(h_.w) + bflo(l_.w); dst[bj][7] = bfhi(h_.w) + bfhi(l_.w); } } } while (0)
        ER_LOAD(xa, r0);
#pragma unroll
        for (int i = 0; i < 8; ++i) { const int ai = i >> 2, m = i & 3; const int row = r0 + ai * 128 + m * 16; float ss = 0.f;
            if (i < 7) ER_LOAD(xn_, r0 + ((i + 1) >> 2) * 128 + ((i + 1) & 3) * 16);
#pragma unroll
            for (int bj = 0; bj < 2; ++bj) { const size_t o_ = (size_t)row * DM + c0 + bj * 128; float v[8];
#pragma unroll
                for (int e = 0; e < 4; ++e) { v[e] = xa[bj][e] + acc[ai][bj][m][0][e]; v[4 + e] = xa[bj][4 + e] + acc[ai][bj][m][1][e]; }
#pragma unroll
                for (int e = 0; e < 8; ++e) ss += v[e] * v[e];
                v4u hw; hw.x = pg8::cvt_pk_bf16(v[0], v[1]); hw.y = pg8::cvt_pk_bf16(v[2], v[3]); hw.z = pg8::cvt_pk_bf16(v[4], v[5]); hw.w = pg8::cvt_pk_bf16(v[6], v[7]);
                v4u lw; lw.x = pg8::cvt_pk_bf16(v[0] - bflo(hw.x), v[1] - bfhi(hw.x)); lw.y = pg8::cvt_pk_bf16(v[2] - bflo(hw.y), v[3] - bfhi(hw.y));
                lw.z = pg8::cvt_pk_bf16(v[4] - bflo(hw.z), v[5] - bfhi(hw.z)); lw.w = pg8::cvt_pk_bf16(v[6] - bflo(hw.w), v[7] - bfhi(hw.w));
                *(GAS v4u*)(xhi + o_) = hw; if (RESID_LO) *(GAS v4u*)(xlo + o_) = lw; }
            ss += shx(ss, 16, lane); ss += shx(ss, 32, lane);
            if (fq == 0) ((GAS float*)rss)[(size_t)row * 32 + (un.pn & 7) * 4 + wc] = ss;
#pragma unroll
            for (int bj = 0; bj < 2; ++bj)
#pragma unroll
                for (int e = 0; e < 8; ++e) xa[bj][e] = xn_[bj][e]; }
#undef ER_LOAD
    }
};
struct EpiRelu2 {
    static constexpr bool PERM = true;
    bf16* h; const float* rss; mutable int pm_c = -1; mutable float rsv_c[8] = {};
    __device__ __forceinline__ void operator()(const f32x4 (&acc)[2][2][4][2], const Unit& un, int wr, int wc, int fr, int fq) const {
        asm volatile("" : "+v"(fr), "+v"(fq));
        const int r0 = un.pm * 256 + wr * 64 + fr, lane = 16 * fq + fr, r0m = un.pm * 256 + wr * 64 + (lane >> 2), c0m = un.pn * 256 + wc * 32 + 8 * (lane & 3);
        if (pm_c != un.pm) { rs_rows_tile(rss, r0, fq, 16 * fq + fr, rsv_c); pm_c = un.pm; }
        const float (&rsv)[8] = rsv_c;
#pragma unroll
        for (int ai = 0; ai < 2; ++ai)
#pragma unroll
            for (int m = 0; m < 4; ++m) { bf16* rowp = h + (size_t)(r0m + ai * 128 + m * 16) * FF + c0m; const float rs = rsv[ai * 4 + m];
#pragma unroll
                for (int bj = 0; bj < 2; ++bj) { f32x4 v0 = acc[ai][bj][m][0] * rs, v1 = acc[ai][bj][m][1] * rs;
#pragma unroll
                    for (int e = 0; e < 4; ++e) { const float a = v0[e] > 0.f ? v0[e] : 0.f, b = v1[e] > 0.f ? v1[e] : 0.f; v0[e] = a * a; v1[e] = b * b; }
                    v4u w; w.x = pg8::cvt_pk_bf16(v0[0], v0[1]); w.y = pg8::cvt_pk_bf16(v0[2], v0[3]); w.z = pg8::cvt_pk_bf16(v1[0], v1[1]); w.w = pg8::cvt_pk_bf16(v1[2], v1[3]);
                    *(GAS v4u*)(rowp + bj * 128) = lanes_to_mem(w, lane); } }
    }
};
struct SchedCross {
    const char* xn; const char* wq; const char* mn; const char* wkv; int G, c;
    __device__ __forceinline__ bool next(int i, Unit& u) const {
        const int L = i * G + c; if (L >= 72) return false;
        if (L < 64) { u.pm = L >> 1; u.pn = L & 1; u.kind = 0; }
        else { u.pm = (L - 64) & 1; u.pn = (L - 64) >> 1; u.kind = 1; }
        return true;
    }
    __device__ __forceinline__ void ptrs(const Unit& u, const char*& a, const char*& b, int& nt) const {
        nt = DM / 64;
        if (u.kind == 0) { a = xn + (size_t)u.pm * TSTEP_DM; b = wq + (size_t)u.pn * TSTEP_DM; }
        else { a = mn + (size_t)u.pm * TSTEP_DM; b = wkv + (size_t)u.pn * TSTEP_DM; }
    }
};
struct EpiCross {
    static constexpr bool PERM = true;
    bf16* qx; bf16* kx; bf16* vxT; const float* rss;
    __device__ __forceinline__ void operator()(const f32x4 (&acc)[2][2][4][2], const Unit& un, int wr, int wc, int fr, int fq) const {
        asm volatile("" : "+v"(fr), "+v"(fq));
        bf16* base = (un.kind == 0) ? qx : kx; const int ldo = (un.kind == 0) ? CRW : 2 * CRW;
        const int r0 = un.pm * 256 + wr * 64 + fr, c0 = un.pn * 256 + wc * 32 + 8 * fq;
        float rsv[8]; rs_rows_tile(rss, (un.kind == 0) ? r0 : wr * 64 + fr, fq, 16 * fq + fr, rsv);
#pragma unroll
        for (int ai = 0; ai < 2; ++ai)
#pragma unroll
            for (int m = 0; m < 4; ++m) { bf16* rowp = base + (size_t)(r0 + ai * 128 + m * 16) * ldo + c0;
                const float rs = (un.kind == 0) ? rsv[ai * 4 + m] : 1.0f;
#pragma unroll
                for (int bj = 0; bj < 2; ++bj) { const f32x4 v0 = acc[ai][bj][m][0] * rs, v1 = acc[ai][bj][m][1] * rs;
                    v4u w; w.x = pg8::cvt_pk_bf16(v0[0], v0[1]); w.y = pg8::cvt_pk_bf16(v0[2], v0[3]); w.z = pg8::cvt_pk_bf16(v1[0], v1[1]); w.w = pg8::cvt_pk_bf16(v1[2], v1[3]);
                    *(GAS v4u*)(rowp + bj * 128) = w; } }
    }
};

__device__ __forceinline__ void lds_barrier() { asm volatile("s_waitcnt lgkmcnt(0)" ::: "memory"); __builtin_amdgcn_s_barrier(); asm volatile("" ::: "memory"); }
__device__ __forceinline__ unsigned off_b(unsigned row, unsigned ch) { return 256u * row + 16u * (ch ^ (((row & 3) << 2) | ((row >> 2) & 3))); }
__device__ __forceinline__ unsigned tr_read_addr_16(unsigned lane, unsigned c, unsigned t) {
    const unsigned g = lane >> 4, q = (lane & 15) >> 2, p = lane & 3;
    return off_b(8 * g + 4 * t + q, 2 * c + (p >> 1)) + 8 * (p & 1);
}
__device__ __forceinline__ s16x4 tr_read(LAS unsigned char* p) { return __builtin_amdgcn_ds_read_tr16_b64_v4i16((LAS s16x4*)p); }

struct AttnState { f32x4 o[8]; float m, l; };
__device__ __forceinline__ void attn_softmax_step(AttnState& A, float (&x)[8], unsigned vmask, bf16x8& bp, int lane) {
    float mx = -1e30f;
#pragma unroll
    for (int e = 0; e < 8; ++e) { x[e] = ((vmask >> e) & 1u) ? x[e] : -1e30f; mx = fmaxf(mx, x[e]); }
    mx = fmaxf(mx, shx(mx, 16, lane)); mx = fmaxf(mx, shx(mx, 32, lane));
    if (__builtin_amdgcn_ballot_w64(mx > A.m + 8.0f) != 0ull) {
        const float mn = fmaxf(A.m, mx), alpha = __builtin_amdgcn_exp2f(A.m - mn);
        A.l *= alpha; A.m = mn;
#pragma unroll
        for (int c = 0; c < 8; ++c) A.o[c] *= alpha;
    }
    float p[8], sum = 0.f;
#pragma unroll
    for (int e = 0; e < 8; ++e) { p[e] = ((vmask >> e) & 1u) ? __builtin_amdgcn_exp2f(x[e] - A.m) : 0.f; sum += p[e]; }
    sum += shx(sum, 16, lane); sum += shx(sum, 32, lane);
    A.l += sum;
    bp = pack8(p);
}
__device__ __forceinline__ int t5_bucket_dev(int rel) {
    const int n = rel < 0 ? -rel : rel; int b;
    if (n < 8) b = n; else b = 8 + (n >= 15) + (n >= 27) + (n >= 50) + (n >= 91) + (n >= 166) + (n >= 305) + (n >= 559);
    return b + (rel > 0 ? 16 : 0);
}

__device__ __forceinline__ void load_mixer_tables(Frame& F, const float* rpb_l, const float* t5_bias) {
    LAS float* rpb2 = (LAS float*)(F.lds + LDS_RPB); LAS float* t5b2 = (LAS float*)(F.lds + LDS_T5);
    for (int i = (F.wave * 64 + lane_id()); i < 6 * 15 * 31; i += NWAVES * 64) rpb2[i] = ((const GAS float*)rpb_l)[i] * LOG2E;
    for (int i = (F.wave * 64 + lane_id()); i < 6 * 3 * 129; i += NWAVES * 64) { const int h = i / 387, r = i % 387, gv = r / 129, jj = r % 129; const int d = (gv == 0) ? 1 : (gv == 1) ? 4 : 16;
        t5b2[i] = ((const GAS float*)t5_bias)[t5_bucket_dev(d * (jj - 64)) * 6 + h] * LOG2E; }
    __syncthreads();
}

constexpr int BLA_STAGE = 32768;
struct BlaLoad { bf16x8 k[2], v[2]; };
__device__ __forceinline__ void bla_issue(BlaLoad& L, rsrc_t rK, rsrc_t rV, unsigned voffK, unsigned voffV, unsigned soffK, unsigned soffV) {
    L.k[0] = ldb8(rK, voffK, soffK); L.k[1] = ldb8(rK, voffK + 16u, soffK); L.v[0] = ldb8(rV, voffV, soffV); L.v[1] = ldb8(rV, voffV + 16u, soffV);
}
__device__ __forceinline__ void bla_write(const BlaLoad& L, LAS unsigned char* st, int tid) {
    const unsigned row = tid >> 3, c0 = 2 * (tid & 7);
    *(LAS bf16x8*)(st + off_b(row, c0)) = L.k[0]; *(LAS bf16x8*)(st + off_b(row, c0 + 1)) = L.k[1];
    *(LAS bf16x8*)(st + 16384 + off_b(row, c0)) = L.v[0]; *(LAS bf16x8*)(st + 16384 + off_b(row, c0 + 1)) = L.v[1];
}
template <class LI>
__device__ __forceinline__ void bla_substep(AttnState& A, const bf16x8 (&bq)[4], const LAS unsigned char* st, int wo, int lane, const LAS float* tab, const LI& li_) {
    const int g = lane >> 4, li = lane & 15;
    const unsigned row0 = wo + 8 * (li >> 2) + (li & 3);
    const unsigned Xa = ((li & 3) << 2) | (((wo >> 2) + 2 * (li >> 2)) & 3), Xb = ((li & 3) << 2) | (((wo >> 2) + 2 * (li >> 2) + 1) & 3);
    bf16x8 a0[4], a1[4];
#pragma unroll
    for (int ks = 0; ks < 4; ++ks) { a0[ks] = *(const LAS bf16x8*)(st + 256u * row0 + 16u * ((4 * ks + g) ^ Xa)); a1[ks] = *(const LAS bf16x8*)(st + 256u * (row0 + 4) + 16u * ((4 * ks + g) ^ Xb)); }
    float bb[8]; unsigned vmask = 0u;
#pragma unroll
    for (int e = 0; e < 8; ++e) { bool valid; const int ix = li_(e, valid); bb[e] = tab ? tab[ix] : 0.f; vmask |= valid ? (1u << e) : 0u; }
    const unsigned q = (lane & 15) >> 2, p = lane & 3;
    const unsigned X0 = (q << 2) | (((wo >> 2) + 2 * g) & 3), X1 = (q << 2) | (((wo >> 2) + 2 * g + 1) & 3);
    const unsigned rb0 = 16384u + 256u * (wo + 8 * g + q) + 16u * ((p >> 1) ^ (X0 & 1)) + 8u * (p & 1), rx0 = X0 >> 1;
    const unsigned rb1 = 16384u + 256u * (wo + 8 * g + 4 + q) + 16u * ((p >> 1) ^ (X1 & 1)) + 8u * (p & 1), rx1 = X1 >> 1;
    s16x4 tv0[8], tv1[8];
#pragma unroll
    for (int c = 0; c < 8; ++c) { tv0[c] = tr_read((LAS unsigned char*)st + rb0 + ((c ^ rx0) << 5)); tv1[c] = tr_read((LAS unsigned char*)st + rb1 + ((c ^ rx1) << 5)); }
    f32x4 st0 = (f32x4){0.f, 0.f, 0.f, 0.f}, st1 = st0;
#pragma unroll
    for (int ks = 0; ks < 4; ++ks) { st0 = MFMA16(a0[ks], bq[ks], st0); st1 = MFMA16(a1[ks], bq[ks], st1); }
    float x[8], mx = -1e30f;
#pragma unroll
    for (int e = 0; e < 8; ++e) { x[e] = ((vmask >> e) & 1u) ? ((e < 4) ? st0[e & 3] : st1[e & 3]) + bb[e] : -1e30f; mx = fmaxf(mx, x[e]); }
    if (__builtin_amdgcn_ballot_w64(mx > A.m + 8.0f) != 0ull) {
        mx = fmaxf(mx, shx(mx, 16, lane)); mx = fmaxf(mx, shx(mx, 32, lane));
        const float mn = fmaxf(A.m, mx), alpha = __builtin_amdgcn_exp2f(A.m - mn);
        A.l *= alpha; A.m = mn;
#pragma unroll
        for (int c = 0; c < 8; ++c) A.o[c] *= alpha;
    }
    float pr[8], sum = 0.f;
#pragma unroll
    for (int e = 0; e < 8; ++e) { pr[e] = ((vmask >> e) & 1u) ? __builtin_amdgcn_exp2f(x[e] - A.m) : 0.f; sum += pr[e]; }
    A.l += sum;
    const bf16x8 bp = pack8(pr);
#pragma unroll
    for (int c = 0; c < 8; ++c) {
        bf16x8 a; a[0] = tv0[c][0]; a[1] = tv0[c][1]; a[2] = tv0[c][2]; a[3] = tv0[c][3]; a[4] = tv1[c][0]; a[5] = tv1[c][1]; a[6] = tv1[c][2]; a[7] = tv1[c][3];
        A.o[c] = MFMA16(a, bp, A.o[c]);
    }
}
__device__ __forceinline__ float bla_rowsum(const AttnState& A, int lane) { float l = A.l; l += shx(l, 16, lane); l += shx(l, 32, lane); return l; }
template <class VO, class CP>
__device__ __forceinline__ void bla_pipeline(LAS unsigned char* lds, int tid, int NT, rsrc_t rK, rsrc_t rV, unsigned soffK, unsigned soffV, const VO& voffs, const CP& compute) {
    BlaLoad LA, LB; unsigned vK, vV;
    voffs(0, vK, vV); bla_issue(LA, rK, rV, vK, vV, soffK, soffV);
    if (NT > 1) { voffs(1, vK, vV); bla_issue(LB, rK, rV, vK, vV, soffK, soffV); }
    bla_write(LA, lds, tid);
    if (NT > 2) { voffs(2, vK, vV); bla_issue(LA, rK, rV, vK, vV, soffK, soffV); }
    lds_barrier();
    for (int t = 0; t < NT; t += 2) {
        if (t + 1 < NT) bla_write(LB, lds + BLA_STAGE, tid);
        if (t + 3 < NT) { voffs(t + 3, vK, vV); bla_issue(LB, rK, rV, vK, vV, soffK, soffV); }
        compute(t, (const LAS unsigned char*)lds);
        lds_barrier();
        if (t + 1 < NT) {
            if (t + 2 < NT) bla_write(LA, lds, tid);
            if (t + 4 < NT) { voffs(t + 4, vK, vV); bla_issue(LA, rK, rV, vK, vV, soffK, soffV); }
            compute(t + 1, (const LAS unsigned char*)(lds + BLA_STAGE));
            lds_barrier();
        }
    }
}

__device__ __forceinline__ void na_unit(Frame& F, int unit, const bf16* u, bf16* omix) {
    const LAS float* rpb2 = (const LAS float*)(F.lds + LDS_RPB);
    int lane = lane_id(); asm volatile("" : "+v"(lane)); const int g = lane >> 4, li = lane & 15, w = F.wave, tid = w * 64 + lane;
    const int rp = unit & 31, h = (unit >> 5) % 6, b = unit / 192;
    const int r = 2 * rp + (w >> 2), j = w & 3, qi = 16 * j + li;
    const size_t tq = (size_t)b * SEQ + r * 64 + qi;
    const int R0 = min(max(2 * rp - 4, 0), 56), R1 = min(max(2 * rp - 3, 0), 56), NT = R1 + 8 - R0;
    const int r0w = min(max(r - 4, 0), 56), cl = min(max(16 * j - 8, 0), 32), c0q = min(max(qi - 8, 0), 48);
    const rsrc_t rU = mk_rsrc(u, SZ_U);
    bf16x8 bq[4];
#pragma unroll
    for (int ks = 0; ks < 4; ++ks) bq[ks] = ldb8(rU, (unsigned)(qi * INW + 8 * g) * 2u, (unsigned)((((size_t)b * SEQ + r * 64) * INW + U_QA + h * 128 + 32 * ks) * 2));
    AttnState A;
#pragma unroll
    for (int c = 0; c < 8; ++c) A.o[c] = (f32x4){0.f, 0.f, 0.f, 0.f};
    A.m = -1e30f; A.l = 0.f;
    const LAS float* rp_ = rpb2 + h * 465;
    const unsigned vrow = (unsigned)((tid >> 3) * INW) * 2u + 32u * (tid & 7);
    const unsigned sbase = (unsigned)((((size_t)b * SEQ + R0 * 64) * INW + h * 128) * 2);
    bla_pipeline(F.lds, tid, NT, rU, rU, sbase + U_KA * 2, sbase + U_VA * 2,
        [&](int t, unsigned& vK, unsigned& vV) { vK = vV = vrow + (unsigned)(t * 64 * INW) * 2u; },
        [&](int t, const LAS unsigned char* st) { const int kr = R0 + t;
            if (kr >= r0w && kr < r0w + 8)
                bla_substep(A, bq, st, cl, lane, rp_, [&](int e, bool& valid) { const int kc = cl + 8 * g + e; valid = (kc >= c0q) && (kc < c0q + 16);
                    return valid ? ((kr - r + 7) * 31 + (kc - qi + 15)) : 0; }); });
    const float inv = 1.0f / bla_rowsum(A, lane);
    bf16* op = omix + tq * MIXW + h * 128 + 4 * g;
#pragma unroll
    for (int c = 0; c < 8; ++c) { v2u wv; wv.x = pk2(A.o[c][0] * inv, A.o[c][1] * inv); wv.y = pk2(A.o[c][2] * inv, A.o[c][3] * inv); *(GAS v2u*)(op + 16 * c) = wv; }
}

template <int VIEW>
__device__ __forceinline__ void dil_unit(Frame& F, int unit, const bf16* u, bf16* po, float* pl) {
    constexpr int DD = (VIEW == 0) ? 1 : (VIEW == 1) ? 4 : 16, DL = SEQ / DD, BPC = DL / 128;
    const LAS float* t5b2 = (const LAS float*)(F.lds + LDS_T5);
    int lane = lane_id(); asm volatile("" : "+v"(lane)); const int g = lane >> 4, li = lane & 15, w = F.wave, tid = w * 64 + lane;
    const int blk = unit & 31, h = (unit >> 5) % 6, b = unit / 192;
    const int rho = blk / BPC, P0 = 128 * (blk % BPC), KP0 = P0 - 64;
    const int qp = P0 + 16 * w + li;
    const size_t tb = (size_t)b * SEQ + rho, tq = tb + (size_t)DD * qp;
    const rsrc_t rU = mk_rsrc(u, SZ_U);
    bf16x8 bq[4];
#pragma unroll
    for (int ks = 0; ks < 4; ++ks) bq[ks] = ldb8(rU, (unsigned)((size_t)DD * (16 * w + li) * INW + 8 * g) * 2u, (unsigned)(((tb + (size_t)DD * P0) * INW + U_QC + h * 128 + 32 * ks) * 2));
    AttnState A;
#pragma unroll
    for (int c = 0; c < 8; ++c) A.o[c] = (f32x4){0.f, 0.f, 0.f, 0.f};
    A.m = -1e30f; A.l = 0.f;
    const LAS float* bias = t5b2 + (h * 3 + VIEW) * 129;
    const unsigned sbase = (unsigned)((tb * INW + h * 128) * 2);
    const int s_lo = w >> 1;
    bla_pipeline(F.lds, tid, 4, rU, rU, sbase + U_KC * 2, sbase + U_VC * 2,
        [&](int t, unsigned& vK, unsigned& vV) { const int kp = min(max(KP0 + 64 * t + (tid >> 3), 0), DL - 1); vK = vV = (unsigned)((size_t)DD * kp * INW) * 2u + 32u * (tid & 7); },
        [&](int t, const LAS unsigned char* st) {
#pragma unroll
            for (int hf = 0; hf < 2; ++hf) { const int ss = 2 * t + hf;
                if (ss >= s_lo && ss <= s_lo + 4)
                    bla_substep(A, bq, st, 32 * hf, lane, bias, [&](int e, bool& valid) { const int kp = KP0 + 32 * ss + 8 * g + e, dl = kp - qp; valid = (kp >= 0) && (kp < DL) && (dl >= -64) && (dl <= 64);
                        return valid ? dl + 64 : 0; }); } });
    const float lsum = bla_rowsum(A, lane), inv = 1.0f / lsum, lse = A.m + __builtin_amdgcn_logf(lsum);
    bf16* pp = po + ((size_t)VIEW * MT + tq) * 768 + h * 128 + 4 * g;
#pragma unroll
    for (int c = 0; c < 8; ++c) { v2u wv; wv.x = pk2(A.o[c][0] * inv, A.o[c][1] * inv); wv.y = pk2(A.o[c][2] * inv, A.o[c][3] * inv); *(GAS v2u*)(pp + 16 * c) = wv; }
    if (g == 0) ((GAS float*)pl)[((size_t)VIEW * MT + tq) * 8 + h] = lse;
}
__device__ __forceinline__ void combine_tasks(Frame& F, const bf16* po, const float* pl, bf16* omix) {
    int lane = lane_id(); asm volatile("" : "+v"(lane));
    for (int task = opq(F.gw); task < MT * 6; task += opq(F.ngw)) {
        const int h = task % 6; const size_t tq = task / 6;
        const float l1 = ((const GAS float*)pl)[tq * 8 + h], l4 = ((const GAS float*)pl)[((size_t)MT + tq) * 8 + h], l16 = ((const GAS float*)pl)[((size_t)2 * MT + tq) * 8 + h];
        const float mx = fmaxf(l1, fmaxf(l4, l16));
        const float w1 = __builtin_amdgcn_exp2f(l1 - mx), w4 = __builtin_amdgcn_exp2f(l4 - mx), w16 = __builtin_amdgcn_exp2f(l16 - mx), wi = 1.0f / (w1 + w4 + w16);
        const size_t off = tq * 768 + h * 128 + 2 * lane;
        const unsigned ua = *(const GAS unsigned*)(po + off), ub = *(const GAS unsigned*)(po + (size_t)MT * 768 + off), uc = *(const GAS unsigned*)(po + (size_t)2 * MT * 768 + off);
        const f32x2 a = {bflo(ua), bfhi(ua)}, b4 = {bflo(ub), bfhi(ub)}, c16 = {bflo(uc), bfhi(uc)};
        const f32x2 o = (a * w1 + b4 * w4 + c16 * w16) * wi;
        *(GAS unsigned*)(omix + tq * MIXW + 1792 + h * 128 + 2 * lane) = pk2(o[0], o[1]);
    }
}

template <class LD, class IS, class WR, class CP>
__device__ __forceinline__ void tile_pipeline(LAS unsigned char* lds, const int stage_bytes, const int NT, const IS& issue, const WR& write, const CP& compute) {
    LD LA, LB;
    issue(0, LA); if (NT > 1) issue(1, LB);
    write(LA, lds); if (NT > 2) issue(2, LA);
    lds_barrier();
    for (int t = 0; t < NT; t += 2) {
        if (t + 1 < NT) write(LB, lds + stage_bytes);
        if (t + 3 < NT) issue(t + 3, LB);
        compute(t, (const LAS unsigned char*)lds);
        lds_barrier();
        if (t + 1 < NT) {
            if (t + 2 < NT) write(LA, lds);
            if (t + 4 < NT) issue(t + 4, LA);
            compute(t + 1, (const LAS unsigned char*)(lds + stage_bytes));
            lds_barrier();
        }
    }
}
struct RowTile { bf16x8 c[4]; };
__device__ __forceinline__ void rowtile_issue(RowTile& L, rsrc_t r, unsigned voff, unsigned soff) {
#pragma unroll
    for (int j = 0; j < 4; ++j) L.c[j] = ldb8(r, voff + 16u * j, soff);
}
__device__ __forceinline__ void rowtile_write(const RowTile& L, LAS unsigned char* st, int tid) {
    const unsigned row = tid >> 2, c0 = 4 * (tid & 3);
#pragma unroll
    for (int j = 0; j < 4; ++j) *(LAS bf16x8*)(st + off_b(row, c0 + j)) = L.c[j];
}
__device__ __forceinline__ bf16x8 lds_frag(const LAS unsigned char* st, unsigned row, unsigned ch) { return *(const LAS bf16x8*)(st + off_b(row, ch)); }

struct MgLoad { RowTile a, b; };
constexpr int MG_STAGE = 65536;
__device__ __forceinline__ void mini_gemm(LAS unsigned char* lds, int tid, int w, int lane, rsrc_t rA, rsrc_t rB, unsigned pitchA_b, unsigned pitchB_b, unsigned sA, unsigned sB, int npieces, f32x4 (&acc)[2][4]) {
    const int g = lane >> 4, li = lane & 15, rgp = w >> 1, chh = w & 1;
    const unsigned voA = (unsigned)(tid >> 2) * pitchA_b + 64u * (tid & 3), voB = (unsigned)(tid >> 2) * pitchB_b + 64u * (tid & 3);
#pragma unroll
    for (int rt = 0; rt < 2; ++rt)
#pragma unroll
        for (int c = 0; c < 4; ++c) acc[rt][c] = (f32x4){0.f, 0.f, 0.f, 0.f};
    tile_pipeline<MgLoad>(lds, MG_STAGE, npieces,
        [&](int t, MgLoad& L) { rowtile_issue(L.a, rA, voA, sA + 256u * t); rowtile_issue(L.b, rB, voB, sB + 256u * t); },
        [&](const MgLoad& L, LAS unsigned char* st) { rowtile_write(L.a, st, tid); rowtile_write(L.b, st + 32768, tid); },
        [&](int t, const LAS unsigned char* st) {
#pragma unroll
            for (int ks = 0; ks < 4; ++ks) { const bf16x8 a0 = lds_frag(st, 32 * rgp + li, 4 * ks + g), a1 = lds_frag(st, 32 * rgp + 16 + li, 4 * ks + g);
#pragma unroll
                for (int c = 0; c < 4; ++c) { const bf16x8 bb = lds_frag(st + 32768, 64 * chh + 16 * c + li, 4 * ks + g); acc[0][c] = MFMA16(bb, a0, acc[0][c]); acc[1][c] = MFMA16(bb, a1, acc[1][c]); } } });
}
__device__ __forceinline__ void kvproj_unit(Frame& F, int unit, const bf16* mn, const bf16* wkv, bf16* kv) {
    int lane = lane_id(); asm volatile("" : "+v"(lane)); const int g = lane >> 4, li = lane & 15, w = F.wave, tid = w * 64 + lane;
    const int l = unit >> 5, mt = (unit >> 3) & 3, ct = unit & 7;
    const rsrc_t rA = mk_rsrc(mn, SZ_MN), rB = mk_rsrc(wkv, SZ_WCKV);
    f32x4 acc[2][4];
    mini_gemm(F.lds, tid, w, lane, rA, rB, DM * 2, DM * 2, (unsigned)(((size_t)l * MEMT + 128 * mt) * DM * 2), (unsigned)(((size_t)l * 2 * CRW + 128 * ct) * DM * 2), DM / 128, acc);
    bf16* out = kv + (size_t)l * MEMT * 2 * CRW;
#pragma unroll
    for (int rt = 0; rt < 2; ++rt)
#pragma unroll
        for (int c = 0; c < 4; ++c) { const int row = 128 * mt + 32 * (w >> 1) + 16 * rt + li, col = 128 * ct + 64 * (w & 1) + 16 * c + 4 * g;
            v2u wv; wv.x = pk2(acc[rt][c][0], acc[rt][c][1]); wv.y = pk2(acc[rt][c][2], acc[rt][c][3]); *(GAS v2u*)(out + (size_t)row * 2 * CRW + col) = wv; }
}
__device__ __forceinline__ void cross_unit(Frame& F, int unit, const bf16* xb, const bf16* wq, const float* rss, const bf16* kv, bf16* ax) {
    int lane = lane_id(); asm volatile("" : "+v"(lane)); const int g = lane >> 4, li = lane & 15, w = F.wave, tid = w * 64 + lane;
    const int qb = unit & 31, h = (unit >> 5) & 3, b = unit >> 7;
    const size_t t0 = (size_t)b * SEQ + 128 * qb;
    const rsrc_t rX = mk_rsrc(xb, SZ_XN), rW = mk_rsrc(wq, (size_t)CRW * DM * 2), rKV = mk_rsrc(kv, (size_t)MEMT * 2 * CRW * 2);
    LAS unsigned char* qt = F.lds + 98304;
    { f32x4 acc[2][4];
      mini_gemm(F.lds, tid, w, lane, rX, rW, DM * 2, DM * 2, (unsigned)(t0 * DM * 2), (unsigned)((size_t)(h * 128) * DM * 2), DM / 128, acc);
#pragma unroll
      for (int rt = 0; rt < 2; ++rt) { const int row = 32 * (w >> 1) + 16 * rt + li; const float rs = rs_row4(rss, (int)t0 + row, g, lane);
#pragma unroll
          for (int c = 0; c < 4; ++c) { const int col = 64 * (w & 1) + 16 * c + 4 * g; const f32x4 v = acc[rt][c] * rs;
              v2u wv; wv.x = pk2(v[0], v[1]); wv.y = pk2(v[2], v[3]); *(LAS v2u*)(qt + off_b(row, col >> 3) + 2 * (col & 7)) = wv; } } }
    lds_barrier();
    bf16x8 bq[4];
#pragma unroll
    for (int ks = 0; ks < 4; ++ks) bq[ks] = lds_frag(qt, 16 * w + li, 4 * ks + g);
    const size_t tq = t0 + 16 * w + li;
    AttnState A;
#pragma unroll
    for (int c = 0; c < 8; ++c) A.o[c] = (f32x4){0.f, 0.f, 0.f, 0.f};
    A.m = -1e30f; A.l = 0.f;
    const unsigned vrow = (unsigned)((tid >> 3) * 2 * CRW) * 2u + 32u * (tid & 7);
    const unsigned sbase = (unsigned)(((size_t)b * MEML * 2 * CRW + h * 128) * 2);
    bla_pipeline(F.lds, tid, 4, rKV, rKV, sbase, sbase + CRW * 2,
        [&](int t, unsigned& vK, unsigned& vV) { vK = vV = vrow + (unsigned)(t * 64 * 2 * CRW) * 2u; },
        [&](int t, const LAS unsigned char* st) {
#pragma unroll
            for (int hf = 0; hf < 2; ++hf) bla_substep(A, bq, st, 32 * hf, lane, (const LAS float*)nullptr, [&](int e, bool& valid) { valid = true; return 0; }); });
    const float inv = 1.0f / bla_rowsum(A, lane);
    bf16* op = ax + tq * CRW + h * 128 + 4 * g;
#pragma unroll
    for (int c = 0; c < 8; ++c) { v2u wv; wv.x = pk2(A.o[c][0] * inv, A.o[c][1] * inv); wv.y = pk2(A.o[c][2] * inv, A.o[c][3] * inv); *(GAS v2u*)(op + 16 * c) = wv; }
}

struct ScanLoad { RowTile k; bf16x8 v; };
constexpr int SCAN_STAGE = 32768 + 4096;
__device__ __forceinline__ void scan_unit(Frame& F, int unit, const bf16* kbT, const bf16* vbT, bf16* states, const float* decay_l) {
    int lane = lane_id(); asm volatile("" : "+v"(lane)); const int g = lane >> 4, li = lane & 15, a = F.wave, tid = a * 64 + lane;
    const int cs = unit & 15, grp = unit >> 4, dir = grp >> 3, b = (grp >> 2) & 1, h = grp & 3;
    const float lg2 = -__expf(((const GAS float*)decay_l)[dir * 4 + h]) * LOG2E;
    const float gc = __builtin_amdgcn_exp2f(128.f * lg2);
    float wv[8];
#pragma unroll
    for (int e = 0; e < 8; ++e) { const int jt = 8 * (tid & 15) + e; wv[e] = __builtin_amdgcn_exp2f((dir == 0 ? (float)(127 - jt) : (float)jt) * lg2); }
    const rsrc_t rK = mk_rsrc(kbT, SZ_KBT), rV = mk_rsrc(vbT, SZ_VBT);
    const unsigned voK = (unsigned)((tid >> 2) * MT) * 2u + 64u * (tid & 3), voV = (unsigned)(((tid >> 4) & 15) * MT) * 2u + 16u * (tid & 15);
    const unsigned sK = (unsigned)(((size_t)(h * 128) * MT + (size_t)b * SEQ) * 2), sV = (unsigned)(((size_t)(h * 256 + 16 * cs) * MT + (size_t)b * SEQ) * 2);
    bf16* sp = states + ((size_t)((dir * 2 + b) * 4 + h) * 32) * (256 * 128) + (size_t)(16 * cs + li) * 128 + 16 * a + 4 * g;
    f32x4 acc = (f32x4){0.f, 0.f, 0.f, 0.f};
    tile_pipeline<ScanLoad>(F.lds, SCAN_STAGE, 32,
        [&](int t, ScanLoad& L) { const int ch = (dir == 0) ? t : 31 - t; rowtile_issue(L.k, rK, voK, sK + (unsigned)(ch * 128) * 2u); if (a < 4) L.v = ldb8(rV, voV, sV + (unsigned)(ch * 128) * 2u); },
        [&](const ScanLoad& L, LAS unsigned char* st) { rowtile_write(L.k, st, tid);
            if (a < 4) { const v4u vr = __builtin_bit_cast(v4u, L.v); float vw[8];
                vw[0] = bflo(vr.x) * wv[0]; vw[1] = bfhi(vr.x) * wv[1]; vw[2] = bflo(vr.y) * wv[2]; vw[3] = bfhi(vr.y) * wv[3];
                vw[4] = bflo(vr.z) * wv[4]; vw[5] = bfhi(vr.z) * wv[5]; vw[6] = bflo(vr.w) * wv[6]; vw[7] = bfhi(vr.w) * wv[7];
                *(LAS bf16x8*)(st + 32768 + off_b((tid >> 4) & 15, tid & 15)) = pack8(vw); } },
        [&](int t, const LAS unsigned char* st) { const int ch = (dir == 0) ? t : 31 - t;
            { v2u w2; w2.x = pk2(acc[0], acc[1]); w2.y = pk2(acc[2], acc[3]); *(GAS v2u*)(sp + (size_t)ch * (256 * 128)) = w2; }
            acc *= gc;
            bf16x8 ka[4], vb[4];
#pragma unroll
            for (int ks = 0; ks < 4; ++ks) { ka[ks] = lds_frag(st, 16 * a + li, 4 * ks + g); vb[ks] = lds_frag(st + 32768, li, 4 * ks + g); }
#pragma unroll
            for (int ks = 0; ks < 4; ++ks) acc = MFMA16(ka[ks], vb[ks], acc); });
}

template <int T>
__device__ __forceinline__ void ro_piece(const LAS unsigned char* st, f32x4 (&tot)[16], const bf16x8 (&bq)[4], bf16x8 (&bp)[4], int lane, int iq, float xf, float xb, float lf, float lb) {
    const int g = lane >> 4, li = lane & 15;
    if constexpr (T < 4) {
#pragma unroll
        for (int c = 0; c < 8; ++c) { f32x4 t = (f32x4){0.f, 0.f, 0.f, 0.f};
#pragma unroll
            for (int ks = 0; ks < 4; ++ks) t = MFMA16(lds_frag(st, 16 * c + li, 4 * ks + g), bq[ks], t);
            if constexpr (T < 2) tot[8 * (T & 1) + c] = t * xf; else tot[8 * (T & 1) + c] += t * xb; }
    } else if constexpr (T == 4) {
#pragma unroll
        for (int s_ = 0; s_ < 4; ++s_) { f32x4 st0 = (f32x4){0.f, 0.f, 0.f, 0.f}, st1 = st0; const unsigned r0 = 32 * s_ + 8 * (li >> 2) + (li & 3);
#pragma unroll
            for (int ks = 0; ks < 4; ++ks) { st0 = MFMA16(lds_frag(st, r0, 4 * ks + g), bq[ks], st0); st1 = MFMA16(lds_frag(st, r0 + 4, 4 * ks + g), bq[ks], st1); }
            float p[8];
#pragma unroll
            for (int e = 0; e < 8; ++e) { const int jk = 32 * s_ + 8 * g + e, df = iq - jk;
                const float dm = (df >= 0) ? __builtin_amdgcn_exp2f((float)df * lf) : __builtin_amdgcn_exp2f((float)(-df) * lb); p[e] = ((e < 4) ? st0[e & 3] : st1[e & 3]) * dm; }
            bp[s_] = pack8(p); }
    } else {
#pragma unroll
        for (int c = 0; c < 8; ++c)
#pragma unroll
            for (int s_ = 0; s_ < 4; ++s_) tot[8 * (T - 5) + c] = MFMA16(lds_frag(st, 16 * c + li, 4 * s_ + g), bp[s_], tot[8 * (T - 5) + c]);
    }
}
__device__ __forceinline__ void retout_unit(Frame& F, int unit, const bf16* u, const bf16* vbT, const bf16* states, const float* decay_l, bf16* omix) {
    int lane = lane_id(); asm volatile("" : "+v"(lane)); const int g = lane >> 4, li = lane & 15, w = F.wave, tid = w * 64 + lane;
    const int ch = unit & 31, h = (unit >> 5) & 3, b = unit >> 7;
    const rsrc_t rS = mk_rsrc(states, SZ_ST), rU = mk_rsrc(u, SZ_U), rV = mk_rsrc(vbT, SZ_VBT);
    const float lf = -__expf(((const GAS float*)decay_l)[h]) * LOG2E, lb = -__expf(((const GAS float*)decay_l)[4 + h]) * LOG2E;
    const int iq = 16 * w + li;
    const size_t t0 = (size_t)b * SEQ + ch * 128;
    bf16x8 bq[4];
#pragma unroll
    for (int ks = 0; ks < 4; ++ks) bq[ks] = ldb8(rU, (unsigned)(iq * INW + 8 * g) * 2u, (unsigned)(t0 * INW + U_QB + h * 128 + 32 * ks) * 2u);
    const float xf = __builtin_amdgcn_exp2f((float)(iq + 1) * lf), xb = __builtin_amdgcn_exp2f((float)(128 - iq) * lb);
    const unsigned sf = (unsigned)((((0 * 2 + b) * 4 + h) * 32 + ch) * (256 * 128)) * 2u, sb = (unsigned)((((1 * 2 + b) * 4 + h) * 32 + ch) * (256 * 128)) * 2u;
    const unsigned voS = 64u * tid, voU = (unsigned)((tid >> 2) * INW) * 2u + 64u * (tid & 3), voV = (unsigned)((tid >> 2) * MT) * 2u + 64u * (tid & 3);
    const unsigned sU = (unsigned)(t0 * INW + U_KB + h * 128) * 2u, sV = (unsigned)((size_t)(h * 256) * MT + t0) * 2u;
    f32x4 tot[16]; bf16x8 bp[4];
    LAS unsigned char* s0 = F.lds; LAS unsigned char* s1 = F.lds + 32768;
    RowTile LA, LB;
#define RO_ISSUE(L, T) do { if ((T) == 0) rowtile_issue(L, rS, voS, sf); else if ((T) == 1) rowtile_issue(L, rS, voS, sf + 32768u); else if ((T) == 2) rowtile_issue(L, rS, voS, sb); else if ((T) == 3) rowtile_issue(L, rS, voS, sb + 32768u); \
        else if ((T) == 4) rowtile_issue(L, rU, voU, sU); else if ((T) == 5) rowtile_issue(L, rV, voV, sV); else rowtile_issue(L, rV, voV, sV + (unsigned)(128 * MT) * 2u); } while (0)
#define RO_COMP(T, st) ro_piece<T>((const LAS unsigned char*)(st), tot, bq, bp, lane, iq, xf, xb, lf, lb)
    RO_ISSUE(LA, 0); RO_ISSUE(LB, 1); rowtile_write(LA, s0, tid); RO_ISSUE(LA, 2); lds_barrier();
    rowtile_write(LB, s1, tid); RO_ISSUE(LB, 3); RO_COMP(0, s0); lds_barrier();
    rowtile_write(LA, s0, tid); RO_ISSUE(LA, 4); RO_COMP(1, s1); lds_barrier();
    rowtile_write(LB, s1, tid); RO_ISSUE(LB, 5); RO_COMP(2, s0); lds_barrier();
    rowtile_write(LA, s0, tid); RO_ISSUE(LA, 6); RO_COMP(3, s1); lds_barrier();
    rowtile_write(LB, s1, tid);                  RO_COMP(4, s0); lds_barrier();
    rowtile_write(LA, s0, tid);                  RO_COMP(5, s1); lds_barrier();
                                                 RO_COMP(6, s0); lds_barrier();
#undef RO_ISSUE
#undef RO_COMP
    float s1_ = 0.f;
#pragma unroll
    for (int c = 0; c < 16; ++c) s1_ += (tot[c][0] + tot[c][1]) + (tot[c][2] + tot[c][3]);
    s1_ += shx(s1_, 16, lane); s1_ += shx(s1_, 32, lane);
    const float mu = s1_ * (1.f / 256.f); float s2 = 0.f;
#pragma unroll
    for (int c = 0; c < 16; ++c) { const f32x4 d = tot[c] - mu; s2 += (d[0] * d[0] + d[1] * d[1]) + (d[2] * d[2] + d[3] * d[3]); }
    s2 += shx(s2, 16, lane); s2 += shx(s2, 32, lane);
    const float rstd = 1.0f / sqrtf(s2 * (1.f / 256.f) + EPSF);
    const bf16* gp = u + (t0 + iq) * INW + U_GR + h * 256 + 4 * g;
    bf16* op = omix + (t0 + iq) * MIXW + 768 + h * 256 + 4 * g;
#pragma unroll
    for (int c = 0; c < 16; ++c) { const v2u gv = *(const GAS v2u*)(gp + 16 * c); float gt[4] = {bflo(gv.x), bfhi(gv.x), bflo(gv.y), bfhi(gv.y)}; float o[4];
#pragma unroll
        for (int e = 0; e < 4; ++e) { const float sg = gt[e] * sigmoidf_(gt[e]); o[e] = sg * (tot[c][e] - mu) * rstd; }
        v2u w2; w2.x = pk2(o[0], o[1]); w2.y = pk2(o[2], o[3]); *(GAS v2u*)(op + 16 * c) = w2; }
}

__device__ __forceinline__ unsigned char* ws_opq(unsigned char* ws, size_t off) { asm volatile("" : "+s"(ws)); return ws + off; }
__device__ __forceinline__ const float* in_opq(const float* p) { asm volatile("" : "+s"(p)); return p; }
struct Args { const float* in[18]; float* out; unsigned char* ws; int ph_lo, ph_hi; };
constexpr int PH_PER_LAYER = 13, N_PHASES = 1 + DEPTH * PH_PER_LAYER + 1;

__global__ void __launch_bounds__(NWAVES * 64, 2) enc_fwd(Args args) {
    extern __shared__ __attribute__((aligned(16))) unsigned char lds[];
    Frame F;
    F.lds = (LAS unsigned char*)lds;
    F.wave = __builtin_amdgcn_readfirstlane((int)threadIdx.x >> 6);
    F.G = gridDim.x; { const int bx = blockIdx.x; F.vcu = (F.G % 8 == 0) ? (bx % 8) * (F.G / 8) + bx / 8 : bx; }
    F.gw = F.vcu * NWAVES + F.wave; F.ngw = F.G * NWAVES;
    volatile LAS unsigned* MISC = (volatile LAS unsigned*)(F.lds + MISC_OFF);
    for (int i = (F.wave * 64 + lane_id()); i < (LDS_BYTES - LDSCTL_OFF) / 4; i += NWAVES * 64) ((LAS unsigned*)(F.lds + LDSCTL_OFF))[i] = 0u;
    __syncthreads();
    gu32* ctl = (gu32*)(args.ws + WS_CTL);
    if (!MK_LAUNCH_PER_PHASE) (void)xcd_barrier_post((unsigned*)ctl + CW_BAR, MISC + 8, F.wave == 0 && lane_id() == 0);
#define GRID_BAR() do { if (!MK_LAUNCH_PER_PHASE) { XcdBarrier b_; b_.bar = (unsigned*)ws_opq(args.ws, WS_CTL) + CW_BAR; b_.x = xb_xcc_id(); b_.st = (volatile LAS unsigned*)(F.lds + MISC_OFF) + 8; xcd_barrier(b_, F.wave == 0 && lane_id() == 0); } } while (0)
    const int lo = args.ph_lo, hi = args.ph_hi;
#ifndef PHMASK
#define PHMASK 0xffffu
#endif
#define PHK(k) ((k) == 0 ? 0 : (k) == N_PHASES - 1 ? 14 : 1 + ((k) - 1) % PH_PER_LAYER)
#if MK_LAUNCH_PER_PHASE
#define IN(k) (lo <= (k) && (k) < hi)
#else
#define IN(k) ((k) < N_PHASES)
#endif
#define INP(k, kk) (((PHMASK >> (kk)) & 1u) && IN(k))
#define SEAM(k) do { if (IN((k) + 1)) GRID_BAR(); if (PROBE) { int bw_ = (int)blockIdx.x | F.wave; asm volatile("" : "+s"(bw_)); if (bw_ == 0 && lane_id() == 0) ((unsigned long long*)(args.ws + 65536))[(k) + 1] = __builtin_amdgcn_s_memrealtime(); } } while (0)
    if (PROBE && blockIdx.x == 0 && F.wave == 0 && lane_id() == 0) ((unsigned long long*)(args.ws + 65536))[0] = __builtin_amdgcn_s_memrealtime();

#define WSP(T, off) ((T*)ws_opq(args.ws, (off)))
#define INP_(k) in_opq(args.in[(k)])
#define x_in INP_(0)
#define mem INP_(1)
#define t5_bias INP_(2)
#define norm_mix_g INP_(3)
#define w_in INP_(4)
#define na_rpb INP_(5)
#define ret_decay INP_(6)
#define w_branch INP_(7)
#define w_out INP_(8)
#define norm_cross_g INP_(9)
#define norm_mem_g INP_(10)
#define w_cq INP_(11)
#define w_ckv INP_(12)
#define w_co INP_(13)
#define norm_mlp_g INP_(14)
#define w_mlp1 INP_(15)
#define w_mlp2 INP_(16)
#define final_norm_g INP_(17)
#define rope WSP(float, WS_ROPE)
#define Wt_in WSP(bf16, WS_WIN)
#define Wt_br WSP(bf16, WS_WBR)
#define Wt_out WSP(bf16, WS_WOUT)
#define Wt_cq WSP(bf16, WS_WCQ)
#define Wt_ckv WSP(bf16, WS_WCKV)
#define Wt_co WSP(bf16, WS_WCO)
#define Wt_1 WSP(bf16, WS_W1)
#define Wt_2 WSP(bf16, WS_W2)
#define MN WSP(bf16, WS_MN)
#define XLO WSP(bf16, WS_X)
#define XN WSP(bf16, WS_XN)
#define U WSP(bf16, WS_U)
#define H WSP(bf16, WS_H)
#define VBT WSP(bf16, WS_VBT)
#define KBT WSP(bf16, WS_KBT)
#define ST WSP(bf16, WS_ST)
#define OMIX WSP(bf16, WS_OMIX)
#define PO WSP(bf16, WS_PO)
#define PL WSP(float, WS_PL)
#define MPART WSP(float, WS_MPART)
#define MERGED WSP(bf16, WS_MERGED)
#define QX WSP(bf16, WS_QX)
#define KX WSP(bf16, WS_KX)
#define VXT WSP(bf16, WS_VXT)
#define AX WSP(bf16, WS_AX)
#define RSB(i) WSP(float, WS_RS + (size_t)(i) * MT * 32 * 4)

    if (INP(0, 0)) {
        LAS float* scr = (LAS float*)(F.lds + RING_OFF + F.wave * 16384);
        constexpr int I_IN = (DM / 64) * (INW / 32), I_BR = (MIXW / 64) * (DM / 32), I_OUT = (DM / 64) * (DM / 32), I_CQ = (DM / 64) * (CRW / 32), I_CKV = (DM / 64) * (2 * CRW / 32),
                      I_CO = (CRW / 64) * (DM / 32), I_1 = (DM / 64) * (FF / 32), I_2 = (FF / 64) * (DM / 32);
        constexpr int I_LAYER = I_IN + I_BR + I_OUT + I_CQ + I_CKV + I_CO + I_1 + I_2;
        for (int it = opq(F.gw); it < DEPTH * I_CKV; it += opq(F.ngw)) { const int l = it / I_CKV, r = it % I_CKV;
            p0_transpose_item<0>(w_ckv + (size_t)l * DM * 2 * CRW, DM, 2 * CRW, Wt_ckv + (size_t)l * 2 * CRW * DM, scr, r, lane_id()); }
        for (int m = opq(F.gw); m < DEPTH * MEMT; m += opq(F.ngw)) { const int l = m / MEMT, r = m % MEMT; rms_row_to_bf16(mem + (size_t)r * DM, norm_mem_g + (size_t)l * DM, MN + (size_t)m * DM, lane_id()); }
        SEAM(0);
        for (int id = opq(F.vcu); id < 128; id += opq(F.G)) kvproj_unit(F, id, MN, Wt_ckv, KX);
        __syncthreads();
        {
            constexpr int I_L2 = I_LAYER - I_CKV;
            for (int it = opq(F.gw); it < DEPTH * I_L2; it += opq(F.ngw)) {
                const int l = it / I_L2; int r = it % I_L2;
                if (r < I_IN) { p0_transpose_item<1>(w_in + (size_t)l * DM * INW, DM, INW, Wt_in + (size_t)l * INW * DM, scr, r, lane_id(), norm_mix_g + (size_t)l * DM); continue; } r -= I_IN;
                if (r < I_BR) { p0_transpose_item<0>(w_branch + (size_t)l * MIXW * DM, MIXW, DM, Wt_br + (size_t)l * DM * MIXW, scr, r, lane_id()); continue; } r -= I_BR;
                if (r < I_OUT) { p0_transpose_item<0>(w_out + (size_t)l * DM * DM, DM, DM, Wt_out + (size_t)l * DM * DM, scr, r, lane_id()); continue; } r -= I_OUT;
                if (r < I_CQ) { p0_transpose_item<2>(w_cq + (size_t)l * DM * CRW, DM, CRW, Wt_cq + (size_t)l * CRW * DM, scr, r, lane_id(), norm_cross_g + (size_t)l * DM); continue; } r -= I_CQ;
                if (r < I_CO) { p0_transpose_item<0>(w_co + (size_t)l * CRW * DM, CRW, DM, Wt_co + (size_t)l * DM * CRW, scr, r, lane_id()); continue; } r -= I_CO;
                if (r < I_1) { p0_transpose_item<0>(w_mlp1 + (size_t)l * DM * FF, DM, FF, Wt_1 + (size_t)l * FF * DM, scr, r, lane_id(), norm_mlp_g + (size_t)l * DM); continue; } r -= I_1;
                p0_transpose_item<0>(w_mlp2 + (size_t)l * FF * DM, FF, DM, Wt_2 + (size_t)l * DM * FF, scr, r, lane_id());
            }
            GAS float* ropep = (GAS float*)rope;
            for (int e = opq(F.gw) * 64 + lane_id(); e < SEQ * 64; e += opq(F.ngw) * 64) { const int t = e >> 6, i = e & 63; float sn, cs; sincos_f32((float)t * rope_inv_freq(i), sn, cs);
                ropep[e] = cs; ropep[SEQ * 64 + e] = sn; ropep[2 * SEQ * 64 + (size_t)i * SEQ + t] = cs; ropep[3 * SEQ * 64 + (size_t)i * SEQ + t] = sn; }
            for (int m = opq(F.gw); m < MT; m += opq(F.ngw)) row_to_bf16_ss(x_in + (size_t)m * DM, XN + (size_t)m * DM, RSB(0) + (size_t)m * 32, lane_id());
        }
        SEAM(0);
    }

#define LAYER_BODY(l) { \
        const int pb = 1 + l * PH_PER_LAYER; \
        if (INP(pb + 1, 2)) { \
            SchedIn S{(const char*)XN, (const char*)(Wt_in + (size_t)l * INW * DM), opq(F.G), opq((int)blockIdx.x)}; \
            EpiIn E{U, VBT, KBT, rope, RSB(3 * l)}; \
            pg8::gemm_phase<EpiIn, SchedIn, PG8_ALIGN, PG8_SP2>(F.lds + RING_OFF, F.wave, DM, S, E); \
            SEAM(pb + 1); \
        } \
        if (INP(pb + 2, 3)) { \
            load_mixer_tables(F, na_rpb + (size_t)l * 6 * 15 * 31, t5_bias); \
            for (int id = opq(F.vcu); id < 256; id += opq(F.G)) scan_unit(F, id, KBT, VBT, ST, ret_decay + l * 8); \
            for (int id = opq(F.vcu); id < 1536; id += opq(F.G)) { \
                if (id < 384) na_unit(F, id, U, OMIX); \
                else if (id < 768) dil_unit<0>(F, id - 384, U, PO, PL); \
                else if (id < 1152) dil_unit<1>(F, id - 768, U, PO, PL); \
                else dil_unit<2>(F, id - 1152, U, PO, PL); \
            } \
            SEAM(pb + 2); \
        } \
        if (INP(pb + 3, 4)) { \
            for (int id = opq(F.vcu); id < 256; id += opq(F.G)) retout_unit(F, id, U, VBT, ST, ret_decay + l * 8, OMIX); \
            combine_tasks(F, PO, PL, OMIX); \
            SEAM(pb + 3); \
        } \
        if (INP(pb + 4, 5)) { \
            __syncthreads(); \
            SchedBr S{(const char*)OMIX, (const char*)(Wt_br + (size_t)l * DM * MIXW), opq(F.G), opq((int)blockIdx.x)}; \
            EpiBr E{U, MERGED}; \
            pg8::gemm_phase<EpiBr, SchedBr, PG8_ALIGN, PG8_SP2>(F.lds + RING_OFF, F.wave, MIXW, S, E); \
            SEAM(pb + 4); \
        } \
        if (INP(pb + 5, 6)) { \
            SchedPlain S{(const char*)MERGED, (const char*)(Wt_out + (size_t)l * DM * DM), 8, DM, DM / 64, opq(F.G), opq((int)blockIdx.x)}; \
            EpiResid E{(l == 0) ? x_in : (const float*)nullptr, XN, XLO, RSB(3 * l + 1)}; \
            pg8::gemm_phase<EpiResid, SchedPlain, PG8_ALIGN, PG8_SP2>(F.lds + RING_OFF, F.wave, DM, S, E); \
            SEAM(pb + 5); \
        } \
        if (INP(pb + 8, 9)) { \
            for (int id = opq(F.vcu); id < 256; id += opq(F.G)) cross_unit(F, id, XN, Wt_cq + (size_t)l * CRW * DM, RSB(3 * l + 1), KX + (size_t)l * MEMT * 2 * CRW, AX); \
            SEAM(pb + 8); \
        } \
        if (INP(pb + 9, 10)) { \
            SchedPlain S{(const char*)AX, (const char*)(Wt_co + (size_t)l * DM * CRW), 8, CRW, CRW / 64, opq(F.G), opq((int)blockIdx.x)}; \
            EpiResid E{(const float*)nullptr, XN, XLO, RSB(3 * l + 2)}; \
            pg8::gemm_phase<EpiResid, SchedPlain, PG8_ALIGN, PG8_SP2>(F.lds + RING_OFF, F.wave, CRW, S, E); \
            SEAM(pb + 9); \
        } \
        if (INP(pb + 11, 12)) { \
            SchedPlain S{(const char*)XN, (const char*)(Wt_1 + (size_t)l * FF * DM), 32, DM, DM / 64, opq(F.G), opq((int)blockIdx.x)}; \
            EpiRelu2 E{H, RSB(3 * l + 2)}; \
            pg8::gemm_phase<EpiRelu2, SchedPlain, PG8_ALIGN, PG8_SP2>(F.lds + RING_OFF, F.wave, DM, S, E); \
            SEAM(pb + 11); \
        } \
        if (INP(pb + 12, 13)) { \
            SchedPlain S{(const char*)H, (const char*)(Wt_2 + (size_t)l * DM * FF), 8, FF, FF / 64, opq(F.G), opq((int)blockIdx.x)}; \
            EpiResid E{(const float*)nullptr, XN, XLO, RSB(3 * l + 3)}; \
            pg8::gemm_phase<EpiResid, SchedPlain, PG8_ALIGN, PG8_SP2>(F.lds + RING_OFF, F.wave, FF, S, E); \
            SEAM(pb + 12); \
        } \
    }
    LAYER_BODY(0)
    LAYER_BODY(1)
    LAYER_BODY(2)
    LAYER_BODY(3)
#undef LAYER_BODY
    float pscale = 1.0f;
    if (PROBE) {
        float* fr = (float*)(args.ws + 65536 + 4096);
        if (blockIdx.x == 0 && F.wave == 0 && lane_id() == 0) {
            const unsigned long long* st = (const unsigned long long*)(args.ws + 65536);
            unsigned long long ta = 0, tb = 0;
            for (int k = 0; k < N_PHASES - 1; ++k) { const int kk = PHK(k); const unsigned long long d = st[k + 1] - st[k]; if ((PROBE_A >> kk) & 1) ta += d; if ((PROBE_B >> kk) & 1) tb += d; }
            const float tot = (float)(st[N_PHASES - 1] - st[0]);
            __hip_atomic_store(fr, floorf((float)ta / tot * 40.f + PROBE_DITHER) * 0.025f, RLX_AGENT); __hip_atomic_store(fr + 1, floorf((float)tb / tot * 40.f + PROBE_DITHER) * 0.025f, RLX_AGENT);
        }
        GRID_BAR();
        pscale = 1.0f + __hip_atomic_load(fr, RLX_AGENT);
    }
    if (INP(N_PHASES - 1, 14)) {
        for (int m = opq(F.gw); m < MT; m += opq(F.ngw)) rms_row_to_f32(XN + (size_t)m * DM, XLO + (size_t)m * DM, final_norm_g, args.out + (size_t)m * DM, lane_id(), pscale, RSB(12) + (size_t)m * 32);
        if (PROBE) { VM_WAIT(); if (F.gw == 0 && lane_id() == 0) args.out[0] = 20.0f + 100.0f * __hip_atomic_load((float*)(args.ws + 65536 + 4096) + 1, RLX_AGENT); }
    }
#undef IN
#undef SEAM
#undef GRID_BAR
}

extern "C" void kernel_launch(void* const* d_in, const int* in_sizes, int n_in, void* d_out, int out_size, void* d_ws, size_t ws_size, hipStream_t stream) {
    static int grid = 0;
    if (grid == 0) {
        if (n_in != 18 || out_size != MT * DM || ws_size < WS_END) { fprintf(stderr, "kernel_launch: unexpected shapes (n_in %d, out %d, ws %zu < %zu)\n", n_in, out_size, ws_size, (size_t)WS_END); grid = -1; return; }
        int dev = 0, cus = 0, per_cu = 0;
        if (hipGetDevice(&dev) != hipSuccess || hipDeviceGetAttribute(&cus, hipDeviceAttributeMultiprocessorCount, dev) != hipSuccess) { grid = -1; return; }
        if (hipFuncSetAttribute((const void*)enc_fwd, hipFuncAttributeMaxDynamicSharedMemorySize, LDS_BYTES) != hipSuccess) { fprintf(stderr, "kernel_launch: hipFuncSetAttribute failed\n"); grid = -1; return; }
        if (hipOccupancyMaxActiveBlocksPerMultiprocessor(&per_cu, (const void*)enc_fwd, NWAVES * 64, LDS_BYTES) != hipSuccess || per_cu < 1)
            fprintf(stderr, "kernel_launch: occupancy query reports %d workgroups per CU\n", per_cu);
        (void)hipGetLastError();
        grid = cus;
    }
    if (grid < 0) return;
    if (hipMemsetAsync((char*)d_ws + WS_CTL, 0, CTL_ZERO_BYTES, stream) != hipSuccess) return;
    Args a{};
    for (int i = 0; i < 18; ++i) a.in[i] = (const float*)d_in[i];
    a.out = (float*)d_out; a.ws = (unsigned char*)d_ws;
#if MK_LAUNCH_PER_PHASE
    for (int p = 0; p < N_PHASES; ++p) { a.ph_lo = p; a.ph_hi = p + 1; hipLaunchKernelGGL(enc_fwd, dim3(grid), dim3(NWAVES * 64), LDS_BYTES, stream, a); }
#else
    a.ph_lo = 0; a.ph_hi = N_PHASES;
    hipLaunchKernelGGL(enc_fwd, dim3(grid), dim3(NWAVES * 64), LDS_BYTES, stream, a);
#endif
    const hipError_t le = hipPeekAtLastError();
    if (le != hipSuccess) fprintf(stderr, "kernel_launch: launch failed: %s\n", hipGetErrorName(le));
}
```
